# Optimizing an MI355X kernel written in HIP

```python
import jax, jax.numpy as jnp
from jax import lax
import numpy as np

D_MODEL = 2048
BATCH = 1
SEQ = 16384
DEPTH = 1

HEAD_DIM = 128
N_Q_HEADS = D_MODEL // HEAD_DIM
N_KV_HEADS = N_Q_HEADS // 4
Q_PER_KV = N_Q_HEADS // N_KV_HEADS
ATTN_WIDTH = N_Q_HEADS * HEAD_DIM
KV_WIDTH = N_KV_HEADS * HEAD_DIM
AXIS_ROPE_DIM = HEAD_DIM // 2
ROPE_THETA = 10000.0
Q_BLOCK = 128
FOURIER_GROUPS = 8
FOURIER_GROUP_DIM = 128
FOURIER_WIDTH = FOURIER_GROUPS * FOURIER_GROUP_DIM
N_BRANCHES = 2
IN_WIDTH = ATTN_WIDTH + 2 * KV_WIDTH + FOURIER_WIDTH + N_BRANCHES * D_MODEL
SPLIT_POINTS = [ATTN_WIDTH, ATTN_WIDTH + KV_WIDTH, ATTN_WIDTH + 2 * KV_WIDTH,
                ATTN_WIDTH + 2 * KV_WIDTH + FOURIER_WIDTH]
D_FF = ((8 * D_MODEL // 3 + 255) // 256) * 256
MACARON_WEIGHT = 0.5
GRID_W = 64
EPS = 1e-6

kernel_name = "hybrid_gated_fnet_axial_gqa_macaron"


def _rms_norm(x, g):
    xf = x.astype(jnp.float32)
    y = xf * lax.rsqrt(jnp.mean(xf * xf, axis=-1, keepdims=True) + EPS)
    return (y * g.astype(jnp.float32)).astype(x.dtype)


def _swiglu(x, w_gate, w_up, w_down):
    return (jax.nn.silu(x @ w_gate) * (x @ w_up)) @ w_down


def _macaron_ffn(x, pre_g, w_gate, w_up, w_down, post_g):
    return x + MACARON_WEIGHT * _rms_norm(_swiglu(_rms_norm(x, pre_g), w_gate, w_up, w_down), post_g)


def _axial_rope_tables(seq):
    rows = seq // GRID_W
    row = jnp.repeat(jnp.arange(rows, dtype=jnp.float32), GRID_W)
    col = jnp.tile(jnp.arange(GRID_W, dtype=jnp.float32), rows)
    n_freq = AXIS_ROPE_DIM // 2
    inv_freq = ROPE_THETA ** (-jnp.arange(n_freq, dtype=jnp.float32) / n_freq)
    ang_r = row[:, None] * inv_freq
    ang_c = col[:, None] * inv_freq
    return (jnp.cos(ang_r), jnp.sin(ang_r), jnp.cos(ang_c), jnp.sin(ang_c))


def _rotate(xs, cos, sin):
    x1, x2 = jnp.split(xs.astype(jnp.float32), 2, axis=-1)
    c = cos[None, :, None, :]
    s = sin[None, :, None, :]
    return jnp.concatenate([x1 * c - x2 * s, x2 * c + x1 * s], axis=-1)


def _apply_axial_rope(x, tables):
    cos_r, sin_r, cos_c, sin_c = tables
    x_row, x_col = jnp.split(x, 2, axis=-1)
    return jnp.concatenate([_rotate(x_row, cos_r, sin_r), _rotate(x_col, cos_c, sin_c)], axis=-1).astype(x.dtype)


def _blocked_gqa(q, k, v):
    b, s = q.shape[0], q.shape[1]
    n_blk = s // Q_BLOCK
    qb = q.reshape(b, n_blk, Q_BLOCK, N_KV_HEADS, Q_PER_KV, HEAD_DIM).transpose(1, 0, 2, 3, 4, 5)
    scale = HEAD_DIM ** -0.5

    def attend(q_blk):
        sc = jnp.einsum('bqkgd,bskd->bkgqs', q_blk, k, preferred_element_type=jnp.float32) * scale
        p = jax.nn.softmax(sc, axis=-1)
        return jnp.einsum('bkgqs,bskd->bqkgd', p.astype(v.dtype), v)

    o = lax.map(attend, qb)
    return o.transpose(1, 0, 2, 3, 4, 5).reshape(b, s, ATTN_WIDTH)


def _fourier_mix(f):
    b, s = f.shape[0], f.shape[1]
    fg = f.astype(jnp.float32).reshape(b, s, FOURIER_GROUPS, FOURIER_GROUP_DIM)
    mixed = jnp.real(jnp.fft.fft2(fg, axes=(1, 3), norm='ortho'))
    return mixed.reshape(b, s, FOURIER_WIDTH).astype(f.dtype)


def _gated_mixers(h, pre_g, w_in, b_gate, q_norm_g, k_norm_g, w_attn_o, w_fourier, w_out, post_g, rope):
    b, s, _ = h.shape
    u = _rms_norm(h, pre_g)
    q, k, v, f, g = jnp.split(u @ w_in, SPLIT_POINTS, axis=-1)
    q = _apply_axial_rope(_rms_norm(q.reshape(b, s, N_Q_HEADS, HEAD_DIM), q_norm_g), rope)
    k = _apply_axial_rope(_rms_norm(k.reshape(b, s, N_KV_HEADS, HEAD_DIM), k_norm_g), rope)
    v = v.reshape(b, s, N_KV_HEADS, HEAD_DIM)
    y_attn = _blocked_gqa(q, k, v) @ w_attn_o
    y_four = _fourier_mix(f) @ w_fourier
    gates = jax.nn.sigmoid((g.reshape(b, s, N_BRANCHES, D_MODEL) + b_gate).astype(jnp.float32)).astype(h.dtype)
    merged = gates[:, :, 0] * y_attn + gates[:, :, 1] * y_four
    return h + _rms_norm(merged @ w_out, post_g)


def setup_inputs(seed: int = 0) -> dict:
    key = jax.random.key(seed)
    ks = jax.random.split(key, 21)

    def w(k, shape, fan_in):
        return jax.random.normal(k, shape, jnp.float32) * (fan_in ** -0.5)

    def gain(k, shape):
        return 1.0 + 0.05 * jax.random.normal(k, shape, jnp.float32)

    L = DEPTH
    return {
        "x": jax.random.normal(ks[0], (BATCH, SEQ, D_MODEL), jnp.float32),
        "ffn1_pre_g": gain(ks[1], (L, D_MODEL)),
        "ffn1_w_gate": w(ks[2], (L, D_MODEL, D_FF), D_MODEL),
        "ffn1_w_up": w(ks[3], (L, D_MODEL, D_FF), D_MODEL),
        "ffn1_w_down": w(ks[4], (L, D_FF, D_MODEL), D_FF),
        "ffn1_post_g": gain(ks[5], (L, D_MODEL)),
        "mix_pre_g": gain(ks[6], (L, D_MODEL)),
        "w_in": w(ks[7], (L, D_MODEL, IN_WIDTH), D_MODEL),
        "b_gate": 0.1 * jax.random.normal(ks[8], (L, N_BRANCHES, D_MODEL), jnp.float32),
        "q_norm_g": gain(ks[9], (L, HEAD_DIM)),
        "k_norm_g": gain(ks[10], (L, HEAD_DIM)),
        "w_attn_o": w(ks[11], (L, ATTN_WIDTH, D_MODEL), ATTN_WIDTH),
        "w_fourier": w(ks[12], (L, FOURIER_WIDTH, D_MODEL), FOURIER_WIDTH),
        "w_out": w(ks[13], (L, D_MODEL, D_MODEL), D_MODEL),
        "mix_post_g": gain(ks[14], (L, D_MODEL)),
        "ffn2_pre_g": gain(ks[15], (L, D_MODEL)),
        "ffn2_w_gate": w(ks[16], (L, D_MODEL, D_FF), D_MODEL),
        "ffn2_w_up": w(ks[17], (L, D_MODEL, D_FF), D_MODEL),
        "ffn2_w_down": w(ks[18], (L, D_FF, D_MODEL), D_FF),
        "ffn2_post_g": gain(ks[19], (L, D_MODEL)),
    }


def reference(x, ffn1_pre_g, ffn1_w_gate, ffn1_w_up, ffn1_w_down, ffn1_post_g,
              mix_pre_g, w_in, b_gate, q_norm_g, k_norm_g, w_attn_o, w_fourier, w_out, mix_post_g,
              ffn2_pre_g, ffn2_w_gate, ffn2_w_up, ffn2_w_down, ffn2_post_g):
    rope = _axial_rope_tables(x.shape[1])
    h = x
    for l in range(DEPTH):
        h = _macaron_ffn(h, ffn1_pre_g[l], ffn1_w_gate[l], ffn1_w_up[l], ffn1_w_down[l], ffn1_post_g[l])
        h = _gated_mixers(h, mix_pre_g[l], w_in[l], b_gate[l], q_norm_g[l], k_norm_g[l],
                          w_attn_o[l], w_fourier[l], w_out[l], mix_post_g[l], rope)
        h = _macaron_ffn(h, ffn2_pre_g[l], ffn2_w_gate[l], ffn2_w_up[l], ffn2_w_down[l], ffn2_post_g[l])
    return h
```

```cpp
#include <hip/hip_runtime.h>
#include <hip/hip_bf16.h>
#include <hip/hip_cooperative_groups.h>
#include <cstdio>
#include <cstdint>
namespace cg = cooperative_groups;

#ifndef MK_PER_PHASE
#define MK_PER_PHASE 1
#endif

namespace pg8 {
#define PG8_LAS __attribute__((address_space(3)))
typedef unsigned short bf16_t;
typedef short bf16x8 __attribute__((ext_vector_type(8)));
typedef float f32x4 __attribute__((ext_vector_type(4)));
typedef unsigned u32x4 __attribute__((ext_vector_type(4)));
constexpr int BM = 256, BK = 64, HALF = 128, HTB = HALF * BK * 2, STAGE_BYTES = 8 * HTB, NXCD = 8, WGM = 8;

__host__ __device__ __forceinline__ int lds_byte(int r, int c) { const int st = (r >> 4) * 2 + (c >> 5), rr = r & 15, cc = c & 31, ob = rr * 64 + cc * 2; return st * 1024 + (ob ^ (((ob >> 9) & 1) << 5)); }
__host__ __device__ __forceinline__ void stage_rc(int b, int& R, int& C) { const int st = b / 1024, sb = b % 1024, swz = sb ^ (((sb >> 9) & 1) << 5); R = (st >> 1) * 16 + swz / 64; C = (st & 1) * 32 + (swz % 64) / 2; }
__host__ __device__ __forceinline__ int perm32(int rho) { const int n = rho >> 4, i = rho & 15; return 8 * (i >> 2) + 4 * n + (i & 3); }

struct Unit { int pm, pn; };
struct Gemm { const char* A; const char* B; };
template <unsigned ROWA_, unsigned ROWB_, size_t HA_, size_t HB_, size_t PMA_, size_t PNA_, size_t PMB_, size_t PNB_, int K_> struct Cfg {
    static constexpr unsigned rowA = ROWA_, rowB = ROWB_; static constexpr size_t hstepA = HA_, hstepB = HB_, pmA = PMA_, pnA = PNA_, pmB = PMB_, pnB = PNB_; static constexpr int K = K_; };
template <int LDA, int LDB, int K_> using StdCfg = Cfg<(unsigned)LDA * 2u, (unsigned)LDB * 2u, (size_t)128 * LDA * 2, (size_t)128 * LDB * 2, (size_t)256 * LDA * 2, 0, 0, (size_t)256 * LDB * 2, K_>;

struct StaticOrder {
    int nM, nN, nwg, G, c;
    __host__ __device__ void init(int M, int N, int G_, int c_) { nM = M / BM; nN = N / BM; nwg = nM * nN; G = G_; c = c_; }
    __host__ __device__ bool next(int i, Unit& u) const {
        const long L = (long)i * G + c; if (L >= nwg) return false;
        int wgid = (int)L; { const int q = nwg / NXCD, r = nwg % NXCD, xcd = wgid % NXCD, off = wgid / NXCD; wgid = (xcd < r ? xcd * (q + 1) : r * (q + 1) + (xcd - r) * q) + off; }
        const int nig = WGM * nN, gid = wgid / nig, fm = gid * WGM, gsz = (nM - fm) < WGM ? (nM - fm) : WGM;
        u.pm = fm + ((wgid % nig) % gsz); u.pn = (wgid % nig) / gsz; return true;
    }
};

__device__ __forceinline__ unsigned cvt_pk_bf16(float lo, float hi) { unsigned r; asm volatile("v_cvt_pk_bf16_f32 %0, %1, %2" : "=v"(r) : "v"(lo), "v"(hi)); return r; }
__device__ __forceinline__ float bf_lo(unsigned w) { return __uint_as_float(w << 16); }
__device__ __forceinline__ float bf_hi(unsigned w) { return __uint_as_float(w & 0xffff0000u); }
__device__ __forceinline__ u32x4 pack8(const f32x4 a, const f32x4 b) { u32x4 w; w.x = cvt_pk_bf16(a[0], a[1]); w.y = cvt_pk_bf16(a[2], a[3]); w.z = cvt_pk_bf16(b[0], b[1]); w.w = cvt_pk_bf16(b[2], b[3]); return w; }
__device__ __forceinline__ float sigmoidf_(float x) { return __builtin_amdgcn_rcpf(1.f + __builtin_amdgcn_exp2f(-1.4426950408889634f * x)); }


struct EpiStore {
    static constexpr bool PERM = true;
    bf16_t* O; int ldc;
    __device__ __forceinline__ void operator()(const f32x4 (&acc)[2][2][4][2], const Unit& u, int wr, int wc, int fr, int fq) const {
        const int row0 = u.pm * BM + wr * 64 + fr, col0 = u.pn * BM + wc * 32 + 8 * fq;
#pragma unroll
        for (int ai = 0; ai < 2; ++ai)
#pragma unroll
            for (int m = 0; m < 4; ++m) { bf16_t* rowp = O + (size_t)(row0 + ai * HALF + m * 16) * ldc + col0;
#pragma unroll
                for (int bj = 0; bj < 2; ++bj) *(u32x4*)(rowp + bj * HALF) = pack8(acc[ai][bj][m][0], acc[ai][bj][m][1]); }
    }
};
struct EpiSwiglu {
    static constexpr bool PERM = true;
    bf16_t* O; int ldc;
    __device__ __forceinline__ void operator()(const f32x4 (&acc)[2][2][4][2], const Unit& u, int wr, int wc, int fr, int fq) const {
        const int row0 = u.pm * BM + wr * 64 + fr, col0 = u.pn * HALF + wc * 32 + 8 * fq;
#pragma unroll
        for (int ai = 0; ai < 2; ++ai)
#pragma unroll
            for (int m = 0; m < 4; ++m) { bf16_t* rowp = O + (size_t)(row0 + ai * HALF + m * 16) * ldc + col0;
                f32x4 v[2];
#pragma unroll
                for (int n = 0; n < 2; ++n) { const f32x4 g = acc[ai][0][m][n], up = acc[ai][1][m][n];
#pragma unroll
                    for (int j = 0; j < 4; ++j) v[n][j] = g[j] * sigmoidf_(g[j]) * up[j]; }
                *(u32x4*)rowp = pack8(v[0], v[1]); }
    }
};
template <bool ACCUM> struct EpiGate {
    static constexpr bool PERM = true;
    bf16_t* O; int ldc; const bf16_t* Gt; int ldg; const float* bias;
    __device__ __forceinline__ void operator()(const f32x4 (&acc)[2][2][4][2], const Unit& u, int wr, int wc, int fr, int fq) const {
        const int row0 = u.pm * BM + wr * 64 + fr, col0 = u.pn * BM + wc * 32 + 8 * fq;
        f32x4 bv[2][2];
#pragma unroll
        for (int bj = 0; bj < 2; ++bj)
#pragma unroll
            for (int n = 0; n < 2; ++n) bv[bj][n] = *(const f32x4*)(bias + col0 + bj * HALF + 4 * n);
#pragma unroll
        for (int ai = 0; ai < 2; ++ai)
#pragma unroll
            for (int m = 0; m < 4; ++m) { const size_t r = (size_t)(row0 + ai * HALF + m * 16);
#pragma unroll
                for (int bj = 0; bj < 2; ++bj) { const u32x4 gw = *(const u32x4*)(Gt + r * ldg + col0 + bj * HALF);
                    f32x4 g0 = {bf_lo(gw.x), bf_hi(gw.x), bf_lo(gw.y), bf_hi(gw.y)}, g1 = {bf_lo(gw.z), bf_hi(gw.z), bf_lo(gw.w), bf_hi(gw.w)};
                    g0 = g0 + bv[bj][0]; g1 = g1 + bv[bj][1];
                    f32x4 v0, v1;
#pragma unroll
                    for (int j = 0; j < 4; ++j) { v0[j] = sigmoidf_(g0[j]) * acc[ai][bj][m][0][j]; v1[j] = sigmoidf_(g1[j]) * acc[ai][bj][m][1][j]; }
                    bf16_t* op = O + r * ldc + col0 + bj * HALF;
                    if (ACCUM) { const u32x4 ow = *(const u32x4*)op;
                        v0 = v0 + (f32x4){bf_lo(ow.x), bf_hi(ow.x), bf_lo(ow.y), bf_hi(ow.y)}; v1 = v1 + (f32x4){bf_lo(ow.z), bf_hi(ow.z), bf_lo(ow.w), bf_hi(ow.w)}; }
                    *(u32x4*)op = pack8(v0, v1); } }
    }
};
struct EpiZt {
    static constexpr bool PERM = true;
    bf16_t* Z;
    __device__ __forceinline__ void operator()(const f32x4 (&acc)[2][2][4][2], const Unit& u, int wr, int wc, int fr, int fq) const {
        const int a0 = wc * 32 + 8 * fq;
#pragma unroll
        for (int ai = 0; ai < 2; ++ai)
#pragma unroll
            for (int m = 0; m < 4; ++m) { const int mi = wr * 64 + m * 16 + fr;
#pragma unroll
                for (int bj = 0; bj < 2; ++bj) { const int b = 2 * u.pn + bj;
                    *(u32x4*)(Z + ((size_t)((u.pm * 128 + mi) * 128 + b)) * 256 + ai * 128 + a0) = pack8(acc[ai][bj][m][0], acc[ai][bj][m][1]); } }
    }
};
struct EpiYt {
    static constexpr bool PERM = true;
    bf16_t* Y; const float* tw;
    __device__ __forceinline__ void operator()(const f32x4 (&acc)[2][2][4][2], const Unit& u, int wr, int wc, int fr, int fq) const {
        const int b0 = wc * 32 + 8 * fq;
#pragma unroll
        for (int m = 0; m < 4; ++m) { const int c = wr * 64 + m * 16 + fr;
            f32x4 t[4];
#pragma unroll
            for (int q = 0; q < 4; ++q) t[q] = *(const f32x4*)(tw + ((size_t)c * 128 + b0) * 2 + 4 * q);
#pragma unroll
            for (int bj = 0; bj < 2; ++bj) { const int gm = 2 * u.pn + bj;
                f32x4 re[2], im[2];
#pragma unroll
                for (int n = 0; n < 2; ++n)
#pragma unroll
                    for (int j = 0; j < 4; ++j) { const int e = 4 * n + j; const float tc = t[e >> 1][(e & 1) * 2], ts = t[e >> 1][(e & 1) * 2 + 1];
                        const float xr = acc[0][bj][m][n][j], xi = acc[1][bj][m][n][j];
                        re[n][j] = xr * tc - xi * ts; im[n][j] = xr * ts + xi * tc; }
                bf16_t* p = Y + ((size_t)(c * 1024 + gm) * 2) * 128 + b0;
                *(u32x4*)p = pack8(re[0], re[1]); *(u32x4*)(p + 128) = pack8(im[0], im[1]); } }
    }
};
struct EpiXf {
    static constexpr bool PERM = true;
    bf16_t* X; int ldx;
    __device__ __forceinline__ void operator()(const f32x4 (&acc)[2][2][4][2], const Unit& u, int wr, int wc, int fr, int fq) const {
        const int c = u.pn >> 2, gm0 = (u.pn & 3) * 256 + wc * 32 + 8 * fq;
#pragma unroll
        for (int m = 0; m < 4; ++m) { const int d = wr * 64 + m * 16 + fr;
#pragma unroll
            for (int bj = 0; bj < 2; ++bj) *(u32x4*)(X + (size_t)(c + 128 * d) * ldx + gm0 + bj * HALF) = pack8(acc[0][bj][m][0], acc[0][bj][m][1]); }
    }
};

template <class C, class Epi, class Sched, bool ALIGN_EPI = false, bool SP2 = false>
__device__ __forceinline__ void gemm_phase(PG8_LAS unsigned char* lds, const Gemm g, const Sched& S, const Epi& E) {
    const int tid = threadIdx.x, wid = __builtin_amdgcn_readfirstlane(tid >> 6), lane = tid & 63, wr = wid >> 2, wc = wid & 3, fr = lane & 15, fq = lane >> 4;
    constexpr int K = C::K, nt = K / BK;
    unsigned voffA[2], voffB[2];
#pragma unroll
    for (int i = 0; i < 2; ++i) { int R, Cc; stage_rc(tid * 16 + i * 8192, R, Cc); const int Rb = Epi::PERM ? ((R & ~31) + perm32(R & 31)) : R;
        voffA[i] = (unsigned)R * C::rowA + (unsigned)Cc * 2u; voffB[i] = (unsigned)Rb * C::rowB + (unsigned)Cc * 2u; }
    const size_t kstep = (size_t)(BK * 2);
    constexpr size_t hstepA = C::hstepA, hstepB = C::hstepB;
    const unsigned ldsw = (unsigned)wid * 1024u;
    const int aoff = lds_byte(wr * 64 + fr, fq * 8), boff = lds_byte(wc * 32 + fr, fq * 8);
#define PG8_SA(b, h) (((b) * 2 + (h)) * HTB)
#define PG8_SB(b, h) ((4 + (b) * 2 + (h)) * HTB)
#define PG8_STAGE(bufoff, gbase, voff) do { _Pragma("unroll") for (int _i = 0; _i < 2; ++_i) \
        __builtin_amdgcn_global_load_lds((const unsigned*)((const char*)(gbase) + (voff)[_i]), (PG8_LAS unsigned*)(lds + (bufoff) + ldsw + _i * 8192), 16, 0, 0); } while (0)
#define PG8_LDA(dst, b, h) do { _Pragma("unroll") for (int m = 0; m < 4; ++m) _Pragma("unroll") for (int k = 0; k < 2; ++k) dst[m][k] = *(const PG8_LAS bf16x8*)(lds + PG8_SA(b, h) + aoff + m * 2048 + k * 1024); } while (0)
#define PG8_LDB(dst, b, h) do { _Pragma("unroll") for (int n = 0; n < 2; ++n) _Pragma("unroll") for (int k = 0; k < 2; ++k) dst[n][k] = *(const PG8_LAS bf16x8*)(lds + PG8_SB(b, h) + boff + n * 2048 + k * 1024); } while (0)
#define PG8_MMA(ai, bj, At, Bt) do { __builtin_amdgcn_s_setprio(1); _Pragma("unroll") for (int m = 0; m < 4; ++m) _Pragma("unroll") for (int n = 0; n < 2; ++n) _Pragma("unroll") for (int k = 0; k < 2; ++k) \
        acc[ai][bj][m][n] = __builtin_amdgcn_mfma_f32_16x16x32_bf16(Bt[n][k], At[m][k], acc[ai][bj][m][n], 0, 0, 0); __builtin_amdgcn_s_setprio(0); } while (0)
#define PG8_WAIT_V(n) asm volatile("s_waitcnt vmcnt(" #n ")" ::: "memory")
#define PG8_WAIT_L(n) asm volatile("s_waitcnt lgkmcnt(" #n ")" ::: "memory")
#define PG8_BAR __builtin_amdgcn_s_barrier()
#define PG8_SCHED __builtin_amdgcn_sched_barrier(0)
#define PG8_TA(u) (g.A + (size_t)(u).pm * C::pmA + (size_t)(u).pn * C::pnA)
#define PG8_TB(u) (g.B + (size_t)(u).pm * C::pmB + (size_t)(u).pn * C::pnB)
    Unit cur, nxt; int ui = 0;
    if (!S.next(0, cur)) return;
    f32x4 acc[2][2][4][2];
#pragma unroll
    for (int a = 0; a < 2; ++a)
#pragma unroll
        for (int b = 0; b < 2; ++b)
#pragma unroll
            for (int m = 0; m < 4; ++m)
#pragma unroll
                for (int n = 0; n < 2; ++n) acc[a][b][m][n] = (f32x4){0.f, 0.f, 0.f, 0.f};
    bf16x8 At[4][2], B0[2][2], B1[2][2];
    const char* cA = PG8_TA(cur); const char* cB = PG8_TB(cur);
    if constexpr (SP2) {
        PG8_STAGE(PG8_SB(0, 0), cB, voffB); PG8_STAGE(PG8_SB(0, 1), cB + hstepB, voffB); PG8_STAGE(PG8_SA(0, 0), cA, voffA); PG8_STAGE(PG8_SA(0, 1), cA + hstepA, voffA);
        if (wr == 1) PG8_BAR;
        PG8_WAIT_V(2); PG8_BAR;
        PG8_STAGE(PG8_SB(1, 0), cB + kstep, voffB); PG8_STAGE(PG8_SA(1, 0), cA + kstep, voffA); PG8_STAGE(PG8_SB(1, 1), cB + hstepB + kstep, voffB);
        PG8_WAIT_V(6); PG8_BAR;
    } else {
        PG8_STAGE(PG8_SB(0, 0), cB, voffB); PG8_STAGE(PG8_SA(0, 0), cA, voffA); PG8_STAGE(PG8_SB(0, 1), cB + hstepB, voffB); PG8_STAGE(PG8_SA(0, 1), cA + hstepA, voffA);
        if (wr == 1) PG8_BAR;
        PG8_WAIT_V(4); PG8_BAR;
        PG8_STAGE(PG8_SB(1, 0), cB + kstep, voffB); PG8_STAGE(PG8_SA(1, 0), cA + kstep, voffA); PG8_STAGE(PG8_SB(1, 1), cB + hstepB + kstep, voffB);
        PG8_WAIT_V(6); PG8_BAR;
    }
    for (;;) {
        const bool has_next = S.next(ui + 1, nxt);
        const char* nA = has_next ? PG8_TA(nxt) : cA; const char* nB = has_next ? PG8_TB(nxt) : cB;
#pragma nounroll
        for (int t = 0; t < nt; t += 2) {
            const bool last = (t == nt - 2);
            const char* a1 = cA + (size_t)(t + 1) * kstep;
            const char* a2 = last ? nA : cA + (size_t)(t + 2) * kstep; const char* b2 = last ? nB : cB + (size_t)(t + 2) * kstep;
            const char* a3 = a2 + kstep; const char* b3 = b2 + kstep;
            if constexpr (SP2) {
            PG8_LDB(B0, 0, 0); PG8_LDB(B1, 0, 1); PG8_SCHED; PG8_LDA(At, 0, 0); PG8_STAGE(PG8_SA(1, 1), a1 + hstepA, voffA);
            PG8_WAIT_V(8); PG8_WAIT_L(0); PG8_BAR; PG8_MMA(0, 0, At, B0); PG8_MMA(0, 1, At, B1); PG8_BAR; PG8_SCHED;
            PG8_LDA(At, 0, 1); PG8_STAGE(PG8_SB(0, 0), b2, voffB); PG8_STAGE(PG8_SB(0, 1), b2 + hstepB, voffB); PG8_STAGE(PG8_SA(0, 0), a2, voffA);
            PG8_WAIT_V(8); PG8_WAIT_L(0); PG8_BAR; PG8_MMA(1, 0, At, B0); PG8_MMA(1, 1, At, B1); PG8_BAR; PG8_SCHED;
            PG8_LDB(B0, 1, 0); PG8_LDB(B1, 1, 1); PG8_SCHED; PG8_LDA(At, 1, 0); PG8_STAGE(PG8_SA(0, 1), a2 + hstepA, voffA);
            PG8_WAIT_V(8); PG8_WAIT_L(0); PG8_BAR; PG8_MMA(0, 0, At, B0); PG8_MMA(0, 1, At, B1); PG8_BAR; PG8_SCHED;
            PG8_LDA(At, 1, 1); PG8_STAGE(PG8_SB(1, 0), b3, voffB); PG8_STAGE(PG8_SB(1, 1), b3 + hstepB, voffB); PG8_STAGE(PG8_SA(1, 0), a3, voffA);
            PG8_WAIT_V(8); PG8_WAIT_L(0); PG8_BAR; PG8_MMA(1, 0, At, B0); PG8_MMA(1, 1, At, B1); PG8_BAR; PG8_SCHED;
            } else {
            PG8_LDB(B0, 0, 0); PG8_SCHED; PG8_LDA(At, 0, 0); PG8_STAGE(PG8_SA(1, 1), a1 + hstepA, voffA);
            PG8_WAIT_L(8); PG8_BAR; PG8_WAIT_L(0); PG8_MMA(0, 0, At, B0); PG8_BAR; PG8_SCHED;
            PG8_LDB(B1, 0, 1); PG8_STAGE(PG8_SB(0, 0), b2, voffB);
            PG8_BAR; PG8_WAIT_L(0); PG8_MMA(0, 1, At, B1); PG8_BAR;
            PG8_LDA(At, 0, 1); PG8_STAGE(PG8_SA(0, 0), a2, voffA);
            PG8_BAR; PG8_WAIT_L(0); PG8_MMA(1, 0, At, B0); PG8_BAR; PG8_SCHED;
            PG8_STAGE(PG8_SB(0, 1), b2 + hstepB, voffB);
            PG8_WAIT_V(6); PG8_BAR; PG8_MMA(1, 1, At, B1); PG8_BAR;
            PG8_LDB(B0, 1, 0); PG8_SCHED; PG8_LDA(At, 1, 0); PG8_STAGE(PG8_SA(0, 1), a2 + hstepA, voffA);
            PG8_WAIT_L(8); PG8_BAR; PG8_WAIT_L(0); PG8_MMA(0, 0, At, B0); PG8_BAR; PG8_SCHED;
            PG8_LDB(B1, 1, 1); PG8_STAGE(PG8_SB(1, 0), b3, voffB);
            PG8_BAR; PG8_WAIT_L(0); PG8_MMA(0, 1, At, B1); PG8_BAR;
            PG8_LDA(At, 1, 1); PG8_STAGE(PG8_SA(1, 0), a3, voffA);
            PG8_BAR; PG8_WAIT_L(0); PG8_MMA(1, 0, At, B0); PG8_BAR; PG8_SCHED;
            PG8_STAGE(PG8_SB(1, 1), b3 + hstepB, voffB);
            PG8_WAIT_V(6); PG8_BAR; PG8_MMA(1, 1, At, B1); PG8_BAR;
            }
        }
        if constexpr (ALIGN_EPI) { if (wr == 0) PG8_BAR; }
        E(acc, cur, wr, wc, fr, fq);
        if (!has_next) break;
#pragma unroll
        for (int a = 0; a < 2; ++a)
#pragma unroll
            for (int b = 0; b < 2; ++b)
#pragma unroll
                for (int m = 0; m < 4; ++m)
#pragma unroll
                    for (int n = 0; n < 2; ++n) acc[a][b][m][n] = (f32x4){0.f, 0.f, 0.f, 0.f};
        cur = nxt; cA = nA; cB = nB; ++ui;
        if constexpr (ALIGN_EPI) { if (wr == 1) PG8_BAR; }
    }
    PG8_WAIT_V(0);
    if constexpr (!ALIGN_EPI) { if (wr == 0) PG8_BAR; }
    PG8_BAR;
#undef PG8_SA
#undef PG8_SB
#undef PG8_STAGE
#undef PG8_LDA
#undef PG8_LDB
#undef PG8_MMA
#undef PG8_WAIT_V
#undef PG8_WAIT_L
#undef PG8_BAR
#undef PG8_SCHED
#undef PG8_TA
#undef PG8_TB
}
}

namespace att {
using bf16 = __hip_bfloat16;
constexpr int   D = 128, NW = 8, QBLK = 32, KVBLK = 64;
constexpr float SCALE = 0.088388347648318440f;
constexpr float THR = 8.f;
constexpr int LDQ = 8192, LDK = 8192, LDO = 8192;
constexpr size_t SHM_V = KVBLK * D * 2, SHM_K = KVBLK * D * 2, SHM_ATTN = 2 * SHM_V + 2 * SHM_K + NW * 64 * 4;
using bf16x8 = __attribute__((ext_vector_type(8))) short;
using s16x4  = __attribute__((ext_vector_type(4))) short;
using f32x16 = __attribute__((ext_vector_type(16))) float;
using u32x4  = __attribute__((ext_vector_type(4))) unsigned;
#define KSWZ(row, colB) ((row) * 256 + ((colB) ^ (((row) & 7) << 4)))
#define SBAR() __builtin_amdgcn_sched_barrier(0)
__device__ __forceinline__ int crow(int r, int hi) { return (r & 3) + 8 * (r >> 2) + 4 * hi; }
__device__ __forceinline__ unsigned cvtpk(float lo, float hi) { unsigned r; asm volatile("v_cvt_pk_bf16_f32 %0, %1, %2" : "=v"(r) : "v"(lo), "v"(hi)); return r; }
__device__ __forceinline__ bf16x8 ld8(const bf16* p) { return *reinterpret_cast<const bf16x8*>(p); }

__device__ __forceinline__ void partialSM(f32x16& p0, f32x16& p1, float& m_reg, float& mn, float& alpha) {
  constexpr float C = SCALE * 1.4426950408889634f;
  float pmax = p0[0]; for (int r = 1; r < 16; ++r) pmax = fmaxf(pmax, p0[r]); for (int r = 0; r < 16; ++r) pmax = fmaxf(pmax, p1[r]);
  { auto rr = __builtin_amdgcn_permlane32_swap(__float_as_uint(pmax), __float_as_uint(pmax), false, false);
    pmax = fmaxf(__uint_as_float(rr[0]), __uint_as_float(rr[1])); }
  if (__builtin_expect(__all(pmax - m_reg <= THR / SCALE), 1)) { mn = m_reg; alpha = 1.f; }
  else { mn = fmaxf(m_reg, pmax); alpha = __builtin_amdgcn_exp2f((m_reg - mn) * C); m_reg = mn; }
  float mnC = -mn * C;
  for (int r = 0; r < 16; ++r) p0[r] = fmaf(p0[r], C, mnC); for (int r = 0; r < 16; ++r) p1[r] = fmaf(p1[r], C, mnC);
  for (int r = 0; r < 16; ++r) p0[r] = __builtin_amdgcn_exp2f(p0[r]);
}
__device__ __forceinline__ void finishSM(f32x16& p0, f32x16& p1, float alpha, float& l_reg, bf16x8& pa0, bf16x8& pa1, bf16x8& pa2, bf16x8& pa3) {
  for (int r = 0; r < 16; ++r) p1[r] = __builtin_amdgcn_exp2f(p1[r]);
  float ps = 0; for (int r = 0; r < 16; ++r) ps += p0[r]; for (int r = 0; r < 16; ++r) ps += p1[r];
  { auto rr = __builtin_amdgcn_permlane32_swap(__float_as_uint(ps), __float_as_uint(ps), false, false);
    ps = __uint_as_float(rr[0]) + __uint_as_float(rr[1]); }
  l_reg = l_reg * alpha + ps;
#define PK4(P, BASE, OUT) do { unsigned a0 = cvtpk(P[BASE + 0], P[BASE + 1]), a1 = cvtpk(P[BASE + 2], P[BASE + 3]);   \
    unsigned b0 = cvtpk(P[BASE + 4], P[BASE + 5]), b1 = cvtpk(P[BASE + 6], P[BASE + 7]);                              \
    auto r0 = __builtin_amdgcn_permlane32_swap(a0, b0, false, false); auto r1 = __builtin_amdgcn_permlane32_swap(a1, b1, false, false); \
    u32x4 w = {r0[0], r1[0], r0[1], r1[1]}; OUT = *reinterpret_cast<bf16x8*>(&w); } while (0)
  PK4(p0, 0, pa0); PK4(p0, 8, pa1); PK4(p1, 0, pa2); PK4(p1, 8, pa3);
#undef PK4
}
__device__ __forceinline__ void qkt(f32x16& p0, f32x16& p1, const bf16* Ks, const bf16x8* qr, int r32, int hi) {
  p0 = f32x16{}; p1 = f32x16{};
  for (int d0 = 0; d0 < 8; ++d0) { int cb = (d0 * 16 + hi * 8) * 2;
    bf16x8 b0 = *reinterpret_cast<const bf16x8*>((const char*)Ks + KSWZ(r32, cb));
    bf16x8 b1 = *reinterpret_cast<const bf16x8*>((const char*)Ks + KSWZ(32 + r32, cb));
    p0 = __builtin_amdgcn_mfma_f32_32x32x16_bf16(b0, qr[d0], p0, 0, 0, 0);
    p1 = __builtin_amdgcn_mfma_f32_32x32x16_bf16(b1, qr[d0], p1, 0, 0, 0); }
}
__device__ __forceinline__ int v_st(int k, int c) { const int kk = (k & ~0xC) | ((k & 4) << 1) | ((k & 8) >> 1); return ((kk >> 3) * 4 + (c >> 5)) * 512 + ((kk & 7) * 32 + (c & 31)) * 2; }
__device__ __forceinline__ int v_rd_base(int lane) { return ((lane & 3) << 3) | (((lane >> 2) & 3) << 6) | (((lane >> 4) & 1) << 5) | (((lane >> 5) & 1) << 8); }
constexpr int v_rd_off(int d0, int ks, int half) { return d0 * 512 + ks * 4096 + half * 2048; }
template <int OFF> __device__ __forceinline__ s16x4 tr_read(int vb) {
  s16x4 r; asm volatile("ds_read_b64_tr_b16 %0, %1 offset:%2" : "=&v"(r) : "v"(vb), "i"(OFF) : "memory"); return r;
}
template <int D0> __device__ __forceinline__ void pv_one(f32x16& od, int vb, bf16x8 pa0, bf16x8 pa1, bf16x8 pa2, bf16x8 pa3) {
  const s16x4 l0 = tr_read<v_rd_off(D0, 0, 0)>(vb), h0 = tr_read<v_rd_off(D0, 0, 1)>(vb), l1 = tr_read<v_rd_off(D0, 1, 0)>(vb), h1 = tr_read<v_rd_off(D0, 1, 1)>(vb);
  const s16x4 l2 = tr_read<v_rd_off(D0, 2, 0)>(vb), h2 = tr_read<v_rd_off(D0, 2, 1)>(vb), l3 = tr_read<v_rd_off(D0, 3, 0)>(vb), h3 = tr_read<v_rd_off(D0, 3, 1)>(vb);
  asm volatile("s_waitcnt lgkmcnt(0)" ::: "memory"); SBAR();
#define PK(L, H) (bf16x8){L[0], L[1], L[2], L[3], H[0], H[1], H[2], H[3]}
  od = __builtin_amdgcn_mfma_f32_32x32x16_bf16(pa0, PK(l0, h0), od, 0, 0, 0);
  od = __builtin_amdgcn_mfma_f32_32x32x16_bf16(pa1, PK(l1, h1), od, 0, 0, 0);
  od = __builtin_amdgcn_mfma_f32_32x32x16_bf16(pa2, PK(l2, h2), od, 0, 0, 0);
  od = __builtin_amdgcn_mfma_f32_32x32x16_bf16(pa3, PK(l3, h3), od, 0, 0, 0);
#undef PK
}
__device__ __forceinline__ void pv_d0(f32x16* o, int vb, bf16x8 pa0, bf16x8 pa1, bf16x8 pa2, bf16x8 pa3) {
  pv_one<0>(o[0], vb, pa0, pa1, pa2, pa3); pv_one<1>(o[1], vb, pa0, pa1, pa2, pa3); pv_one<2>(o[2], vb, pa0, pa1, pa2, pa3); pv_one<3>(o[3], vb, pa0, pa1, pa2, pa3);
}

__device__ __forceinline__ void attn_dense_body(const bf16* Qb, const bf16* __restrict__ Kh, const bf16* __restrict__ Vh,
                                                bf16* Ob, int seq, char* lds) {
  constexpr int SDEPTH = 2;
  const int tid = threadIdx.x, wid = tid >> 6, lane = tid & 63, r32 = lane & 31, hi = lane >> 5;
  bf16* V_lds = (bf16*)lds; bf16* K_lds = (bf16*)(lds + 2 * SHM_V);
  float* ws = (float*)(lds + 2 * SHM_V + 2 * SHM_K) + wid * 64; float* li_l = ws; float* al_l = ws + 32;
  float m_reg = -1e30f, l_reg = 0; f32x16 o[4] = {}; bf16x8 qr[8];
  const bf16* Qw = Qb + (long)(wid * QBLK + r32) * LDQ + hi * 8;
#pragma unroll
  for (int d0 = 0; d0 < 8; ++d0) qr[d0] = ld8(Qw + d0 * 16);
  const int sr = tid >> 4, sc = (tid & 15) * 8, vst0 = v_st(sr, sc), vst1 = v_st(32 + sr, sc);
  const int vb0 = (int)(uintptr_t)V_lds + v_rd_base(lane);
  struct { bf16x8 vs0, vs1, ks0, ks1; } sr_[SDEPTH];
#define SLOAD(i, k0) do { sr_[i].vs0 = ld8(&Vh[(long)((k0) + sr) * LDK + sc]); sr_[i].vs1 = ld8(&Vh[(long)((k0) + 32 + sr) * LDK + sc]); \
    sr_[i].ks0 = ld8(&Kh[(long)((k0) + sr) * LDK + sc]); sr_[i].ks1 = ld8(&Kh[(long)((k0) + 32 + sr) * LDK + sc]); } while (0)
#define SWRITE(b, i) do { *(bf16x8*)((char*)V_lds + (b) * SHM_V + vst0) = sr_[i].vs0;          \
    *(bf16x8*)((char*)V_lds + (b) * SHM_V + vst1) = sr_[i].vs1; int kc = sc * 2;               \
    *(bf16x8*)((char*)K_lds + (b) * SHM_K + KSWZ(sr, kc)) = sr_[i].ks0;                       \
    *(bf16x8*)((char*)K_lds + (b) * SHM_K + KSWZ(32 + sr, kc)) = sr_[i].ks1; } while (0)
#define SWAIT() do { asm volatile("s_waitcnt vmcnt(4)" ::: "memory"); } while (0)
#define RESC(a) do { if (__any((a) < 1.f)) { if (hi == 0) al_l[r32] = (a); asm volatile("s_waitcnt lgkmcnt(0)" ::: "memory"); \
    for (int d = 0; d < 4; ++d) for (int r = 0; r < 16; ++r) o[d][r] *= al_l[crow(r, hi)]; } } while (0)
  f32x16 pA0, pA1, pB0, pB1; float mnA, mnB, alA, alB; bf16x8 pa0, pa1, pa2, pa3; const int NT = seq / KVBLK;
  constexpr int SE = 0, SO = SDEPTH - 1;
  SLOAD(SE, 0); asm volatile("s_waitcnt vmcnt(0)" ::: "memory"); SWRITE(0, SE); __syncthreads();
  qkt(pA0, pA1, K_lds, qr, r32, hi); partialSM(pA0, pA1, m_reg, mnA, alA);
  SLOAD(SO, KVBLK); if (2 < NT) SLOAD(SE, 2 * KVBLK);
  SWAIT(); SWRITE(1, SO); __syncthreads();
  for (int j = 1; j + 1 < NT; j += 2) {
    SBAR(); qkt(pB0, pB1, (bf16*)((char*)K_lds + SHM_K), qr, r32, hi);
    finishSM(pA0, pA1, alA, l_reg, pa0, pa1, pa2, pa3); SBAR();
    SLOAD(SO, (j + SDEPTH) * KVBLK); SBAR();
    pv_d0(o, vb0, pa0, pa1, pa2, pa3); partialSM(pB0, pB1, m_reg, mnB, alB);
    __syncthreads(); SWAIT(); SWRITE(0, SE);
    RESC(alB); __syncthreads();
    SBAR(); qkt(pA0, pA1, K_lds, qr, r32, hi);
    finishSM(pB0, pB1, alB, l_reg, pa0, pa1, pa2, pa3); SBAR();
    if (j + 3 < NT) SLOAD(SE, (j + 1 + SDEPTH) * KVBLK); SBAR();
    pv_d0(o, vb0 + (int)SHM_V, pa0, pa1, pa2, pa3); partialSM(pA0, pA1, m_reg, mnA, alA);
    __syncthreads(); SWAIT(); SWRITE(1, SO);
    RESC(alA); __syncthreads();
  }
  SBAR(); qkt(pB0, pB1, (bf16*)((char*)K_lds + SHM_K), qr, r32, hi);
  finishSM(pA0, pA1, alA, l_reg, pa0, pa1, pa2, pa3); SBAR();
  pv_d0(o, vb0, pa0, pa1, pa2, pa3); partialSM(pB0, pB1, m_reg, mnB, alB);
  __syncthreads(); RESC(alB);
  finishSM(pB0, pB1, alB, l_reg, pa0, pa1, pa2, pa3); SBAR();
  pv_d0(o, vb0 + (int)SHM_V, pa0, pa1, pa2, pa3);
  if (hi == 0) li_l[r32] = l_reg; asm volatile("s_waitcnt lgkmcnt(0)" ::: "memory");
  float rli[16];
#pragma unroll
  for (int r = 0; r < 16; ++r) rli[r] = __builtin_amdgcn_rcpf(li_l[crow(r, hi)]);
  unsigned short* Ow = (unsigned short*)Ob + (long)(wid * QBLK) * LDO;
#pragma unroll
  for (int r = 0; r < 16; ++r) { int orow = crow(r, hi);
#pragma unroll
    for (int d0 = 0; d0 < 4; ++d0) Ow[(long)orow * LDO + d0 * 32 + r32] = (unsigned short)(cvtpk(o[d0][r] * rli[r], 0.f) & 0xffffu); }
#undef SLOAD
#undef SWRITE
#undef SWAIT
#undef RESC
}
}

constexpr int S_ = 16384, DM = 2048, FF = 5632, INW = 8192;
constexpr float EPS = 1e-6f;
constexpr size_t MiB = 1u << 20;
constexpr size_t WS_G1 = 0;
constexpr size_t WS_TW = 256 * 1024;
constexpr size_t WS_W = 1 * MiB;
constexpr size_t WS_WGU = WS_W, WS_WD = WS_W + 44 * MiB;
constexpr size_t WS_WIN = WS_W, WS_WAO = WS_W + 32 * MiB, WS_WF = WS_W + 40 * MiB, WS_WOUT = WS_W + 44 * MiB;
constexpr size_t WS_U = 68 * MiB;
constexpr size_t WS_T = 132 * MiB;
constexpr size_t WS_R1 = 196 * MiB;
constexpr size_t WS_END = 452 * MiB;
constexpr int LDS_BYTES = 147456;
constexpr int NPHASE = 16;

typedef float f32x4 __attribute__((ext_vector_type(4)));
typedef unsigned u32x4 __attribute__((ext_vector_type(4)));
typedef unsigned u32x2 __attribute__((ext_vector_type(2)));
#define LAS __attribute__((address_space(3)))
#define LDS_WAIT() asm volatile("s_waitcnt lgkmcnt(0)" ::: "memory")

__device__ __forceinline__ float wave_sum(float v) {
#pragma unroll
    for (int o = 1; o < 64; o <<= 1) v += __shfl_xor(v, o);
    return v;
}
using pg8::cvt_pk_bf16; using pg8::bf_lo; using pg8::bf_hi;

__device__ __forceinline__ void transpose_item(const float* __restrict__ W, int N, unsigned short* __restrict__ WT, int ldt, int k0, int n0, int drow0, LAS float* scr, int lane) {
#pragma unroll 8
    for (int i = 0; i < 32; ++i) { const int kk = 2 * i + (lane >> 5); scr[kk * 33 + (lane & 31)] = W[(size_t)(k0 + kk) * N + n0 + (lane & 31)]; }
    LDS_WAIT(); asm volatile("" ::: "memory");
    const int c = lane & 7;
#pragma unroll
    for (int j = 0; j < 4; ++j) { const int n = (lane >> 3) + 8 * j; const LAS float* s = scr + (8 * c) * 33 + n;
        u32x4 o; o.x = cvt_pk_bf16(s[0 * 33], s[1 * 33]); o.y = cvt_pk_bf16(s[2 * 33], s[3 * 33]); o.z = cvt_pk_bf16(s[4 * 33], s[5 * 33]); o.w = cvt_pk_bf16(s[6 * 33], s[7 * 33]);
        *(u32x4*)(WT + (size_t)(drow0 + n) * ldt + k0 + 8 * c) = o; }
    LDS_WAIT(); asm volatile("" ::: "memory");
}
__device__ __forceinline__ void transpose_plain(const float* W, int K, int N, unsigned short* WT, int it, LAS float* scr, int lane) {
    const int nblk = N / 32, kb = it / nblk, nb = it % nblk;
    transpose_item(W, N, WT, K, 64 * kb, 32 * nb, 32 * nb, scr, lane);
}
__device__ __forceinline__ void convert_ffn(const float* Wg, const float* Wu, const float* Wd, unsigned short* WGU, unsigned short* WD, LAS float* scr, int gw, int NGW, int lane) {
    constexpr int I_G = (DM / 64) * (FF / 32), I_D = (FF / 64) * (DM / 32);
    for (int it = gw; it < 2 * I_G + I_D; it += NGW) {
        int r = it;
        if (r < 2 * I_G) { const bool up = r >= I_G; if (up) r -= I_G; const int nblk = FF / 32, kb = r / nblk, nb = r % nblk, n0 = 32 * nb;
            transpose_item(up ? Wu : Wg, FF, WGU, DM, 64 * kb, n0, (n0 >> 7) * 256 + (up ? 128 : 0) + (n0 & 127), scr, lane); continue; }
        r -= 2 * I_G; transpose_plain(Wd, FF, DM, WD, r, scr, lane);
    }
}
__device__ __forceinline__ void norm_row(const float* xrow, const float* g, unsigned short* orow, int lane) {
    const f32x4* xr = (const f32x4*)xrow + lane; const f32x4* gr = (const f32x4*)g + lane;
    f32x4 v[8]; float s = 0.f;
#pragma unroll
    for (int j = 0; j < 8; ++j) { v[j] = xr[64 * j]; s += (v[j].x * v[j].x + v[j].y * v[j].y) + (v[j].z * v[j].z + v[j].w * v[j].w); }
    const float rstd = 1.0f / sqrtf(wave_sum(s) * (1.f / DM) + EPS);
    u32x2* o8 = (u32x2*)orow + lane;
#pragma unroll
    for (int j = 0; j < 8; ++j) { const f32x4 gv = gr[64 * j]; u32x2 w; w.x = cvt_pk_bf16(v[j].x * rstd * gv.x, v[j].y * rstd * gv.y); w.y = cvt_pk_bf16(v[j].z * rstd * gv.z, v[j].w * rstd * gv.w); o8[64 * j] = w; }
}
template <bool NEXT>
__device__ __forceinline__ void res_norm_row(const unsigned short* trow, const float* brow, const float* post_g, float wgt, float* orow, const float* pre_g, unsigned short* urow, int lane) {
    const u32x2* tr = (const u32x2*)trow + lane;
    f32x4 t[8]; float s = 0.f;
#pragma unroll
    for (int j = 0; j < 8; ++j) { const u32x2 w = tr[64 * j]; t[j] = (f32x4){bf_lo(w.x), bf_hi(w.x), bf_lo(w.y), bf_hi(w.y)}; s += (t[j].x * t[j].x + t[j].y * t[j].y) + (t[j].z * t[j].z + t[j].w * t[j].w); }
    const float rstd = wgt / sqrtf(wave_sum(s) * (1.f / DM) + EPS);
    float s2 = 0.f;
#pragma unroll
    for (int j = 0; j < 8; ++j) { const f32x4 b = ((const f32x4*)brow + lane)[64 * j]; const f32x4 g = ((const f32x4*)post_g + lane)[64 * j];
        t[j] = b + t[j] * rstd * g; ((f32x4*)orow + lane)[64 * j] = t[j]; s2 += (t[j].x * t[j].x + t[j].y * t[j].y) + (t[j].z * t[j].z + t[j].w * t[j].w); }
    if (NEXT) {
        const float r2 = 1.0f / sqrtf(wave_sum(s2) * (1.f / DM) + EPS);
        u32x2* o8 = (u32x2*)urow + lane;
#pragma unroll
        for (int j = 0; j < 8; ++j) { const f32x4 gv = ((const f32x4*)pre_g + lane)[64 * j]; u32x2 w; w.x = cvt_pk_bf16(t[j].x * r2 * gv.x, t[j].y * r2 * gv.y); w.y = cvt_pk_bf16(t[j].z * r2 * gv.z, t[j].w * r2 * gv.w); o8[64 * j] = w; }
    }
}
__device__ __forceinline__ void qk_rope_row(unsigned short* row, int s, const float* qg, const float* kg, int lane) {
    const int sec = lane >> 5, half = (lane >> 4) & 1, i0 = (2 * lane) & 31;
    const float pos = (float)(sec == 0 ? (s >> 6) : (s & 63));
    const float L = 13.287712379549449f / 32.f;
    float cs[2], sn[2];
#pragma unroll
    for (int e = 0; e < 2; ++e) { const float fr = exp2f(-(float)(i0 + e) * L); float rev = pos * fr * 0.15915494309189535f; rev -= floorf(rev);
        sn[e] = __builtin_amdgcn_sinf(rev); cs[e] = __builtin_amdgcn_cosf(rev); }
    const float gq0 = qg[2 * lane], gq1 = qg[2 * lane + 1], gk0 = kg[2 * lane], gk1 = kg[2 * lane + 1];
    unsigned w[20];
#pragma unroll
    for (int h = 0; h < 20; ++h) w[h] = ((const unsigned*)(row + h * 128))[lane];
#pragma unroll
    for (int h = 0; h < 20; ++h) {
        const float x0 = bf_lo(w[h]), x1 = bf_hi(w[h]);
        const float rstd = 1.0f / sqrtf(wave_sum(x0 * x0 + x1 * x1) * (1.f / 128.f) + EPS);
        const float y0 = x0 * rstd * (h < 16 ? gq0 : gk0), y1 = x1 * rstd * (h < 16 ? gq1 : gk1);
        const float p0 = __shfl_xor(y0, 16), p1 = __shfl_xor(y1, 16);
        const float o0 = half ? (y0 * cs[0] + p0 * sn[0]) : (y0 * cs[0] - p0 * sn[0]);
        const float o1 = half ? (y1 * cs[1] + p1 * sn[1]) : (y1 * cs[1] - p1 * sn[1]);
        ((unsigned*)(row + h * 128))[lane] = cvt_pk_bf16(o0, o1);
    }
}

#define SINGLE_ARG(...) __VA_ARGS__
struct Args { const float* in[20]; float* out; unsigned char* ws; int ph_lo, ph_hi; };

__global__ void __launch_bounds__(512, 2) mk_fwd(Args args) {
    extern __shared__ __attribute__((aligned(16))) unsigned char lds[];
    cg::grid_group grid = cg::this_grid();
    const int tid = threadIdx.x, lane = tid & 63, wave = __builtin_amdgcn_readfirstlane(tid >> 6);
    const int G = gridDim.x, bx = blockIdx.x;
    const int gw = bx * 8 + wave, NGW = G * 8;
    unsigned char* ws = args.ws;
    unsigned short* const G1 = (unsigned short*)(ws + WS_G1); float* const TW = (float*)(ws + WS_TW);
    unsigned short* const U = (unsigned short*)(ws + WS_U); unsigned short* const T = (unsigned short*)(ws + WS_T); unsigned short* const R1 = (unsigned short*)(ws + WS_R1);
    const float* x = args.in[0]; float* out = args.out;
    LAS unsigned char* ldsl = (LAS unsigned char*)lds;
    LAS float* scr = (LAS float*)(ldsl + wave * 16384);
    const int lo = args.ph_lo, hi = args.ph_hi;
#ifndef F1_AL
#define F1_AL false
#endif
#ifndef F1_SP
#define F1_SP true
#endif
#ifndef PHASE_MASK
#define PHASE_MASK 0xFFFF
#endif
#define IN(k) (((PHASE_MASK >> (k)) & 1) && lo <= (k) && (k) < hi)
#define SEAM(k) do { if (IN(k) && IN((k) + 1)) grid.sync(); } while (0)
#define GEMM_PHASE_X(CFG, EPI, AL, SP, Aptr, Bptr, M_, N_, ...) do { pg8::Gemm g_{(const char*)(Aptr), (const char*)(Bptr)}; pg8::StaticOrder So_; So_.init((M_), (N_), G, bx); \
        EPI E_{__VA_ARGS__}; pg8::gemm_phase<CFG, EPI, pg8::StaticOrder, AL, SP>(ldsl, g_, So_, E_); } while (0)
#define GEMM_PHASE(CFG, EPI, ...) GEMM_PHASE_X(SINGLE_ARG(CFG), SINGLE_ARG(EPI), true, true, __VA_ARGS__)
    typedef pg8::Cfg<512u, (unsigned)(128 * INW * 2), (size_t)128 * 512, (size_t)INW * 2, 0, 0, 256, (size_t)2 * INW * 2, 128> CfgF1;
    typedef pg8::Cfg<512u, 512u, (size_t)128 * 512, (size_t)128 * 512, 0, 0, 0, (size_t)256 * 512, 256> CfgF2;

    if (IN(0)) {
        convert_ffn(args.in[2], args.in[3], args.in[4], (unsigned short*)(ws + WS_WGU), (unsigned short*)(ws + WS_WD), scr, gw, NGW, lane);
        for (int e = bx * 512 + tid; e < 256 * 256; e += G * 512) { const int r = e >> 8, c = e & 255, ro = r >> 7, i = r & 127, ri = c >> 7, j = c & 127, a = (i * j) & 127;
            const float cv = cospif((float)a * (1.f / 64.f)), sv = sinpif((float)a * (1.f / 64.f));
            const float v = (ro == ri) ? cv : (ro == 0 ? sv : -sv);
            G1[e] = (unsigned short)(cvt_pk_bf16(v * 0.08838834764831845f, 0.f) & 0xffffu); }
        for (int e = bx * 512 + tid; e < 128 * 128; e += G * 512) { const int c = e >> 7, b = e & 127, a = (b * c) & 16383;
            TW[2 * e] = cospif((float)a * (1.f / 8192.f)); TW[2 * e + 1] = -sinpif((float)a * (1.f / 8192.f)); }
        for (int m = gw; m < S_; m += NGW) norm_row(x + (size_t)m * DM, args.in[1], U + (size_t)m * DM, lane);
    }
    SEAM(0);
    if (IN(1)) GEMM_PHASE(SINGLE_ARG(pg8::StdCfg<DM, DM, DM>), pg8::EpiSwiglu, U, ws + WS_WGU, S_, 2 * FF, R1, FF);
    SEAM(1);
    if (IN(2)) GEMM_PHASE(SINGLE_ARG(pg8::StdCfg<FF, FF, FF>), pg8::EpiStore, R1, ws + WS_WD, S_, DM, T, DM);
    SEAM(2);
    if (IN(3)) {
        for (int m = gw; m < S_; m += NGW) res_norm_row<true>(T + (size_t)m * DM, x + (size_t)m * DM, args.in[5], 0.5f, out + (size_t)m * DM, args.in[6], U + (size_t)m * DM, lane);
        constexpr int I_IN = (DM / 64) * (INW / 32), I_AO = (DM / 64) * (DM / 32), I_F = (1024 / 64) * (DM / 32);
        for (int it = gw; it < I_IN + 2 * I_AO + I_F; it += NGW) { int r = it;
            if (r < I_IN) { transpose_plain(args.in[7], DM, INW, (unsigned short*)(ws + WS_WIN), r, scr, lane); continue; } r -= I_IN;
            if (r < I_AO) { transpose_plain(args.in[11], DM, DM, (unsigned short*)(ws + WS_WAO), r, scr, lane); continue; } r -= I_AO;
            if (r < I_F) { transpose_plain(args.in[12], 1024, DM, (unsigned short*)(ws + WS_WF), r, scr, lane); continue; } r -= I_F;
            transpose_plain(args.in[13], DM, DM, (unsigned short*)(ws + WS_WOUT), r, scr, lane); }
    }
    SEAM(3);
    if (IN(4)) GEMM_PHASE(SINGLE_ARG(pg8::StdCfg<DM, DM, DM>), pg8::EpiStore, U, ws + WS_WIN, S_, INW, R1, INW);
    SEAM(4);
    if (IN(5)) {
        for (int m = gw; m < S_; m += NGW) qk_rope_row(R1 + (size_t)m * INW, m, args.in[9], args.in[10], lane);
        GEMM_PHASE_X(CfgF1, pg8::EpiZt, F1_AL, F1_SP, G1, R1 + 3072, 8 * 256, 64 * 256, U);
    }
    SEAM(5);
    if (IN(6)) GEMM_PHASE(CfgF2, pg8::EpiYt, G1, U, 256, 131072, T, TW);
    SEAM(6);
    if (IN(7)) GEMM_PHASE(CfgF2, pg8::EpiXf, G1, T, 256, 131072, R1 + 3072, INW);
    SEAM(7);
    if (IN(8)) {
        for (int u = bx; u < 1024; u += G) { const int kvh = u >> 8, w = u & 255, qh = 4 * kvh + (w & 3), qb = w >> 2;
            const att::bf16* base = (const att::bf16*)R1;
            __syncthreads();
            att::attn_dense_body(base + (size_t)qb * 256 * INW + qh * 128, base + 2048 + kvh * 128, base + 2560 + kvh * 128,
                                 (att::bf16*)R1 + (size_t)qb * 256 * INW + qh * 128, S_, (char*)lds);
        }
        __syncthreads();
    }
    SEAM(8);
    if (IN(9)) GEMM_PHASE(SINGLE_ARG(pg8::StdCfg<INW, DM, DM>), pg8::EpiGate<false>, R1, ws + WS_WAO, S_, DM, U, DM, R1 + 4096, INW, args.in[8]);
    SEAM(9);
    if (IN(10)) GEMM_PHASE(SINGLE_ARG(pg8::StdCfg<INW, 1024, 1024>), pg8::EpiGate<true>, R1 + 3072, ws + WS_WF, S_, DM, U, DM, R1 + 4096 + DM, INW, args.in[8] + DM);
    SEAM(10);
    if (IN(11)) GEMM_PHASE(SINGLE_ARG(pg8::StdCfg<DM, DM, DM>), pg8::EpiStore, U, ws + WS_WOUT, S_, DM, T, DM);
    SEAM(11);
    if (IN(12)) {
        for (int m = gw; m < S_; m += NGW) res_norm_row<true>(T + (size_t)m * DM, out + (size_t)m * DM, args.in[14], 1.0f, out + (size_t)m * DM, args.in[15], U + (size_t)m * DM, lane);
        convert_ffn(args.in[16], args.in[17], args.in[18], (unsigned short*)(ws + WS_WGU), (unsigned short*)(ws + WS_WD), scr, gw, NGW, lane);
    }
    SEAM(12);
    if (IN(13)) GEMM_PHASE(SINGLE_ARG(pg8::StdCfg<DM, DM, DM>), pg8::EpiSwiglu, U, ws + WS_WGU, S_, 2 * FF, R1, FF);
    SEAM(13);
    if (IN(14)) GEMM_PHASE(SINGLE_ARG(pg8::StdCfg<FF, FF, FF>), pg8::EpiStore, R1, ws + WS_WD, S_, DM, T, DM);
    SEAM(14);
    if (IN(15)) {
        for (int m = gw; m < S_; m += NGW) res_norm_row<false>(T + (size_t)m * DM, out + (size_t)m * DM, args.in[19], 0.5f, out + (size_t)m * DM, nullptr, nullptr, lane);
    }
#undef IN
#undef SEAM
#undef GEMM_PHASE
#undef GEMM_PHASE_X
}

extern "C" void kernel_launch(void* const* d_in, const int* in_sizes, int n_in, void* d_out, int out_size, void* d_ws, size_t ws_size, hipStream_t stream) {
    static int grid = 0;
    if (grid == 0) {
        if (n_in != 20 || in_sizes[0] != S_ * DM || out_size != S_ * DM || ws_size < WS_END) {
            fprintf(stderr, "kernel_launch: shape/workspace mismatch: n_in %d in0 %d out %d ws %zu (need %zu)\n", n_in, n_in > 0 ? in_sizes[0] : -1, out_size, ws_size, (size_t)WS_END); grid = -1; return; }
        int dev = 0, cus = 0, per_cu = 0;
        if (hipGetDevice(&dev) != hipSuccess || hipDeviceGetAttribute(&cus, hipDeviceAttributeMultiprocessorCount, dev) != hipSuccess) { fprintf(stderr, "kernel_launch: device query failed\n"); grid = -1; return; }
        if (hipFuncSetAttribute((const void*)mk_fwd, hipFuncAttributeMaxDynamicSharedMemorySize, LDS_BYTES) != hipSuccess) { fprintf(stderr, "kernel_launch: hipFuncSetAttribute failed\n"); grid = -1; return; }
        if (hipOccupancyMaxActiveBlocksPerMultiprocessor(&per_cu, (const void*)mk_fwd, 512, LDS_BYTES) != hipSuccess || per_cu < 1) { fprintf(stderr, "kernel_launch: occupancy query says %d blocks per CU\n", per_cu); per_cu = 1; }
        (void)hipGetLastError();
        grid = cus;
    }
    if (grid < 0) return;
    Args a{};
    for (int i = 0; i < 20; ++i) a.in[i] = (const float*)d_in[i];
    a.out = (float*)d_out; a.ws = (unsigned char*)d_ws;
#if MK_PER_PHASE
    for (int p = 0; p < NPHASE; ++p) { a.ph_lo = p; a.ph_hi = p + 1;
        hipLaunchKernelGGL(mk_fwd, dim3(grid), dim3(512), LDS_BYTES, stream, a);
        const hipError_t le = hipPeekAtLastError(); if (le != hipSuccess) { fprintf(stderr, "kernel_launch: launch %d failed: %s\n", p, hipGetErrorName(le)); break; } }
#else
    a.ph_lo = 0; a.ph_hi = NPHASE;
    void* kargs[] = {&a};
    const hipError_t e = hipLaunchCooperativeKernel((const void*)mk_fwd, dim3(grid), dim3(512), kargs, LDS_BYTES, stream);
    if (e != hipSuccess) fprintf(stderr, "kernel_launch: cooperative launch failed: %s (grid %d)\n", hipGetErrorString(e), grid);
#endif
}
```

```cpp
#include <hip/hip_runtime.h>
#include <hip/hip_bf16.h>
#include <hip/hip_cooperative_groups.h>
#include <cstdio>
#include <cstdint>
namespace cg = cooperative_groups;

#ifndef MK_PER_PHASE
#define MK_PER_PHASE 0
#endif

namespace pg8 {
#define PG8_LAS __attribute__((address_space(3)))
typedef unsigned short bf16_t;
typedef short bf16x8 __attribute__((ext_vector_type(8)));
typedef float f32x4 __attribute__((ext_vector_type(4)));
typedef unsigned u32x4 __attribute__((ext_vector_type(4)));
constexpr int BM = 256, BK = 64, HALF = 128, HTB = HALF * BK * 2, STAGE_BYTES = 8 * HTB, NXCD = 8, WGM = 8;

__host__ __device__ __forceinline__ int lds_byte(int r, int c) { const int st = (r >> 4) * 2 + (c >> 5), rr = r & 15, cc = c & 31, ob = rr * 64 + cc * 2; return st * 1024 + (ob ^ (((ob >> 9) & 1) << 5)); }
__host__ __device__ __forceinline__ void stage_rc(int b, int& R, int& C) { const int st = b / 1024, sb = b % 1024, swz = sb ^ (((sb >> 9) & 1) << 5); R = (st >> 1) * 16 + swz / 64; C = (st & 1) * 32 + (swz % 64) / 2; }
__host__ __device__ __forceinline__ int perm32(int rho) { const int n = rho >> 4, i = rho & 15; return 8 * (i >> 2) + 4 * n + (i & 3); }

struct Unit { int pm, pn; };
struct Gemm { const char* A; const char* B; };
template <unsigned ROWA_, unsigned ROWB_, size_t HA_, size_t HB_, size_t PMA_, size_t PNA_, size_t PMB_, size_t PNB_, int K_> struct Cfg {
    static constexpr unsigned rowA = ROWA_, rowB = ROWB_; static constexpr size_t hstepA = HA_, hstepB = HB_, pmA = PMA_, pnA = PNA_, pmB = PMB_, pnB = PNB_; static constexpr int K = K_; };
template <int LDA, int LDB, int K_> using StdCfg = Cfg<(unsigned)LDA * 2u, (unsigned)LDB * 2u, (size_t)128 * LDA * 2, (size_t)128 * LDB * 2, (size_t)256 * LDA * 2, 0, 0, (size_t)256 * LDB * 2, K_>;

struct StaticOrder {
    int nM, nN, nwg, G, c;
    __host__ __device__ void init(int M, int N, int G_, int c_) { nM = M / BM; nN = N / BM; nwg = nM * nN; G = G_; c = c_; }
    __host__ __device__ bool next(int i, Unit& u) const {
        const long L = (long)i * G + c; if (L >= nwg) return false;
        int wgid = (int)L; { const int q = nwg / NXCD, r = nwg % NXCD, xcd = wgid % NXCD, off = wgid / NXCD; wgid = (xcd < r ? xcd * (q + 1) : r * (q + 1) + (xcd - r) * q) + off; }
        const int nig = WGM * nN, gid = wgid / nig, fm = gid * WGM, gsz = (nM - fm) < WGM ? (nM - fm) : WGM;
        u.pm = fm + ((wgid % nig) % gsz); u.pn = (wgid % nig) / gsz; return true;
    }
};

__device__ __forceinline__ unsigned cvt_pk_bf16(float lo, float hi) { unsigned r; asm volatile("v_cvt_pk_bf16_f32 %0, %1, %2" : "=v"(r) : "v"(lo), "v"(hi)); return r; }
__device__ __forceinline__ float bf_lo(unsigned w) { return __uint_as_float(w << 16); }
__device__ __forceinline__ float bf_hi(unsigned w) { return __uint_as_float(w & 0xffff0000u); }
__device__ __forceinline__ u32x4 pack8(const f32x4 a, const f32x4 b) { u32x4 w; w.x = cvt_pk_bf16(a[0], a[1]); w.y = cvt_pk_bf16(a[2], a[3]); w.z = cvt_pk_bf16(b[0], b[1]); w.w = cvt_pk_bf16(b[2], b[3]); return w; }
__device__ __forceinline__ float sigmoidf_(float x) { return __builtin_amdgcn_rcpf(1.f + __builtin_amdgcn_exp2f(-1.4426950408889634f * x)); }


struct EpiStore {
    static constexpr bool PERM = true;
    bf16_t* O; int ldc;
    __device__ __forceinline__ void operator()(const f32x4 (&acc)[2][2][4][2], const Unit& u, int wr, int wc, int fr, int fq) const {
        const int row0 = u.pm * BM + wr * 64 + fr, col0 = u.pn * BM + wc * 32 + 8 * fq;
#pragma unroll
        for (int ai = 0; ai < 2; ++ai)
#pragma unroll
            for (int m = 0; m < 4; ++m) { bf16_t* rowp = O + (size_t)(row0 + ai * HALF + m * 16) * ldc + col0;
#pragma unroll
                for (int bj = 0; bj < 2; ++bj) *(u32x4*)(rowp + bj * HALF) = pack8(acc[ai][bj][m][0], acc[ai][bj][m][1]); }
    }
};
struct EpiSwiglu {
    static constexpr bool PERM = true;
    bf16_t* O; int ldc;
    __device__ __forceinline__ void operator()(const f32x4 (&acc)[2][2][4][2], const Unit& u, int wr, int wc, int fr, int fq) const {
        const int row0 = u.pm * BM + wr * 64 + fr, col0 = u.pn * HALF + wc * 32 + 8 * fq;
#pragma unroll
        for (int ai = 0; ai < 2; ++ai)
#pragma unroll
            for (int m = 0; m < 4; ++m) { bf16_t* rowp = O + (size_t)(row0 + ai * HALF + m * 16) * ldc + col0;
                f32x4 v[2];
#pragma unroll
                for (int n = 0; n < 2; ++n) { const f32x4 g = acc[ai][0][m][n], up = acc[ai][1][m][n];
#pragma unroll
                    for (int j = 0; j < 4; ++j) v[n][j] = g[j] * sigmoidf_(g[j]) * up[j]; }
                *(u32x4*)rowp = pack8(v[0], v[1]); }
    }
};
template <bool ACCUM> struct EpiGate {
    static constexpr bool PERM = true;
    bf16_t* O; int ldc; const bf16_t* Gt; int ldg; const float* bias;
    __device__ __forceinline__ void operator()(const f32x4 (&acc)[2][2][4][2], const Unit& u, int wr, int wc, int fr, int fq) const {
        const int row0 = u.pm * BM + wr * 64 + fr, col0 = u.pn * BM + wc * 32 + 8 * fq;
        f32x4 bv[2][2];
#pragma unroll
        for (int bj = 0; bj < 2; ++bj)
#pragma unroll
            for (int n = 0; n < 2; ++n) bv[bj][n] = *(const f32x4*)(bias + col0 + bj * HALF + 4 * n);
#pragma unroll
        for (int ai = 0; ai < 2; ++ai)
#pragma unroll
            for (int m = 0; m < 4; ++m) { const size_t r = (size_t)(row0 + ai * HALF + m * 16);
#pragma unroll
                for (int bj = 0; bj < 2; ++bj) { const u32x4 gw = *(const u32x4*)(Gt + r * ldg + col0 + bj * HALF);
                    f32x4 g0 = {bf_lo(gw.x), bf_hi(gw.x), bf_lo(gw.y), bf_hi(gw.y)}, g1 = {bf_lo(gw.z), bf_hi(gw.z), bf_lo(gw.w), bf_hi(gw.w)};
                    g0 = g0 + bv[bj][0]; g1 = g1 + bv[bj][1];
                    f32x4 v0, v1;
#pragma unroll
                    for (int j = 0; j < 4; ++j) { v0[j] = sigmoidf_(g0[j]) * acc[ai][bj][m][0][j]; v1[j] = sigmoidf_(g1[j]) * acc[ai][bj][m][1][j]; }
                    bf16_t* op = O + r * ldc + col0 + bj * HALF;
                    if (ACCUM) { const u32x4 ow = *(const u32x4*)op;
                        v0 = v0 + (f32x4){bf_lo(ow.x), bf_hi(ow.x), bf_lo(ow.y), bf_hi(ow.y)}; v1 = v1 + (f32x4){bf_lo(ow.z), bf_hi(ow.z), bf_lo(ow.w), bf_hi(ow.w)}; }
                    *(u32x4*)op = pack8(v0, v1); } }
    }
};
struct EpiZt {
    static constexpr bool PERM = true;
    bf16_t* Z;
    __device__ __forceinline__ void operator()(const f32x4 (&acc)[2][2][4][2], const Unit& u, int wr, int wc, int fr, int fq) const {
        const int a0 = wc * 32 + 8 * fq;
#pragma unroll
        for (int ai = 0; ai < 2; ++ai)
#pragma unroll
            for (int m = 0; m < 4; ++m) { const int mi = wr * 64 + m * 16 + fr;
#pragma unroll
                for (int bj = 0; bj < 2; ++bj) { const int b = 2 * u.pn + bj;
                    *(u32x4*)(Z + ((size_t)((u.pm * 128 + mi) * 128 + b)) * 256 + ai * 128 + a0) = pack8(acc[ai][bj][m][0], acc[ai][bj][m][1]); } }
    }
};
struct EpiYt {
    static constexpr bool PERM = true;
    bf16_t* Y; const float* tw;
    __device__ __forceinline__ void operator()(const f32x4 (&acc)[2][2][4][2], const Unit& u, int wr, int wc, int fr, int fq) const {
        const int b0 = wc * 32 + 8 * fq;
#pragma unroll
        for (int m = 0; m < 4; ++m) { const int c = wr * 64 + m * 16 + fr;
            f32x4 t[4];
#pragma unroll
            for (int q = 0; q < 4; ++q) t[q] = *(const f32x4*)(tw + ((size_t)c * 128 + b0) * 2 + 4 * q);
#pragma unroll
            for (int bj = 0; bj < 2; ++bj) { const int gm = 2 * u.pn + bj;
                f32x4 re[2], im[2];
#pragma unroll
                for (int n = 0; n < 2; ++n)
#pragma unroll
                    for (int j = 0; j < 4; ++j) { const int e = 4 * n + j; const float tc = t[e >> 1][(e & 1) * 2], ts = t[e >> 1][(e & 1) * 2 + 1];
                        const float xr = acc[0][bj][m][n][j], xi = acc[1][bj][m][n][j];
                        re[n][j] = xr * tc - xi * ts; im[n][j] = xr * ts + xi * tc; }
                bf16_t* p = Y + ((size_t)(c * 1024 + gm) * 2) * 128 + b0;
                *(u32x4*)p = pack8(re[0], re[1]); *(u32x4*)(p + 128) = pack8(im[0], im[1]); } }
    }
};
struct EpiXf {
    static constexpr bool PERM = true;
    bf16_t* X; int ldx;
    __device__ __forceinline__ void operator()(const f32x4 (&acc)[2][2][4][2], const Unit& u, int wr, int wc, int fr, int fq) const {
        const int c = u.pn >> 2, gm0 = (u.pn & 3) * 256 + wc * 32 + 8 * fq;
#pragma unroll
        for (int m = 0; m < 4; ++m) { const int d = wr * 64 + m * 16 + fr;
#pragma unroll
            for (int bj = 0; bj < 2; ++bj) *(u32x4*)(X + (size_t)(c + 128 * d) * ldx + gm0 + bj * HALF) = pack8(acc[0][bj][m][0], acc[0][bj][m][1]); }
    }
};

template <class C, class Epi, class Sched, bool ALIGN_EPI = false, bool SP2 = false>
__device__ __forceinline__ void gemm_phase(PG8_LAS unsigned char* lds, const Gemm g, const Sched& S, const Epi& E) {
    const int tid = threadIdx.x, wid = __builtin_amdgcn_readfirstlane(tid >> 6), lane = tid & 63, wr = wid >> 2, wc = wid & 3, fr = lane & 15, fq = lane >> 4;
    constexpr int K = C::K, nt = K / BK;
    unsigned voffA[2], voffB[2];
#pragma unroll
    for (int i = 0; i < 2; ++i) { int R, Cc; stage_rc(tid * 16 + i * 8192, R, Cc); const int Rb = Epi::PERM ? ((R & ~31) + perm32(R & 31)) : R;
        voffA[i] = (unsigned)R * C::rowA + (unsigned)Cc * 2u; voffB[i] = (unsigned)Rb * C::rowB + (unsigned)Cc * 2u; }
    const size_t kstep = (size_t)(BK * 2);
    constexpr size_t hstepA = C::hstepA, hstepB = C::hstepB;
    const unsigned ldsw = (unsigned)wid * 1024u;
    const int aoff = lds_byte(wr * 64 + fr, fq * 8), boff = lds_byte(wc * 32 + fr, fq * 8);
#define PG8_SA(b, h) (((b) * 2 + (h)) * HTB)
#define PG8_SB(b, h) ((4 + (b) * 2 + (h)) * HTB)
#define PG8_STAGE(bufoff, gbase, voff) do { _Pragma("unroll") for (int _i = 0; _i < 2; ++_i) \
        __builtin_amdgcn_global_load_lds((const unsigned*)((const char*)(gbase) + (voff)[_i]), (PG8_LAS unsigned*)(lds + (bufoff) + ldsw + _i * 8192), 16, 0, 0); } while (0)
#define PG8_LDA(dst, b, h) do { _Pragma("unroll") for (int m = 0; m < 4; ++m) _Pragma("unroll") for (int k = 0; k < 2; ++k) dst[m][k] = *(const PG8_LAS bf16x8*)(lds + PG8_SA(b, h) + aoff + m * 2048 + k * 1024); } while (0)
#define PG8_LDB(dst, b, h) do { _Pragma("unroll") for (int n = 0; n < 2; ++n) _Pragma("unroll") for (int k = 0; k < 2; ++k) dst[n][k] = *(const PG8_LAS bf16x8*)(lds + PG8_SB(b, h) + boff + n * 2048 + k * 1024); } while (0)
#define PG8_MMA(ai, bj, At, Bt) do { __builtin_amdgcn_s_setprio(1); _Pragma("unroll") for (int m = 0; m < 4; ++m) _Pragma("unroll") for (int n = 0; n < 2; ++n) _Pragma("unroll") for (int k = 0; k < 2; ++k) \
        acc[ai][bj][m][n] = __builtin_amdgcn_mfma_f32_16x16x32_bf16(Bt[n][k], At[m][k], acc[ai][bj][m][n], 0, 0, 0); __builtin_amdgcn_s_setprio(0); } while (0)
#define PG8_WAIT_V(n) asm volatile("s_waitcnt vmcnt(" #n ")" ::: "memory")
#define PG8_WAIT_L(n) asm volatile("s_waitcnt lgkmcnt(" #n ")" ::: "memory")
#define PG8_BAR __builtin_amdgcn_s_barrier()
#define PG8_SCHED __builtin_amdgcn_sched_barrier(0)
#define PG8_TA(u) (g.A + (size_t)(u).pm * C::pmA + (size_t)(u).pn * C::pnA)
#define PG8_TB(u) (g.B + (size_t)(u).pm * C::pmB + (size_t)(u).pn * C::pnB)
    Unit cur, nxt; int ui = 0;
    if (!S.next(0, cur)) return;
    f32x4 acc[2][2][4][2];
#pragma unroll
    for (int a = 0; a < 2; ++a)
#pragma unroll
        for (int b = 0; b < 2; ++b)
#pragma unroll
            for (int m = 0; m < 4; ++m)
#pragma unroll
                for (int n = 0; n < 2; ++n) acc[a][b][m][n] = (f32x4){0.f, 0.f, 0.f, 0.f};
    bf16x8 At[4][2], B0[2][2], B1[2][2];
    const char* cA = PG8_TA(cur); const char* cB = PG8_TB(cur);
    if constexpr (SP2) {
        PG8_STAGE(PG8_SB(0, 0), cB, voffB); PG8_STAGE(PG8_SB(0, 1), cB + hstepB, voffB); PG8_STAGE(PG8_SA(0, 0), cA, voffA); PG8_STAGE(PG8_SA(0, 1), cA + hstepA, voffA);
        if (wr == 1) PG8_BAR;
        PG8_WAIT_V(2); PG8_BAR;
        PG8_STAGE(PG8_SB(1, 0), cB + kstep, voffB); PG8_STAGE(PG8_SA(1, 0), cA + kstep, voffA); PG8_STAGE(PG8_SB(1, 1), cB + hstepB + kstep, voffB);
        PG8_WAIT_V(6); PG8_BAR;
    } else {
        PG8_STAGE(PG8_SB(0, 0), cB, voffB); PG8_STAGE(PG8_SA(0, 0), cA, voffA); PG8_STAGE(PG8_SB(0, 1), cB + hstepB, voffB); PG8_STAGE(PG8_SA(0, 1), cA + hstepA, voffA);
        if (wr == 1) PG8_BAR;
        PG8_WAIT_V(4); PG8_BAR;
        PG8_STAGE(PG8_SB(1, 0), cB + kstep, voffB); PG8_STAGE(PG8_SA(1, 0), cA + kstep, voffA); PG8_STAGE(PG8_SB(1, 1), cB + hstepB + kstep, voffB);
        PG8_WAIT_V(6); PG8_BAR;
    }
    for (;;) {
        const bool has_next = S.next(ui + 1, nxt);
        const char* nA = has_next ? PG8_TA(nxt) : cA; const char* nB = has_next ? PG8_TB(nxt) : cB;
#pragma nounroll
        for (int t = 0; t < nt; t += 2) {
            const bool last = (t == nt - 2);
            const char* a1 = cA + (size_t)(t + 1) * kstep;
            const char* a2 = last ? nA : cA + (size_t)(t + 2) * kstep; const char* b2 = last ? nB : cB + (size_t)(t + 2) * kstep;
            const char* a3 = a2 + kstep; const char* b3 = b2 + kstep;
            if constexpr (SP2) {
            PG8_LDB(B0, 0, 0); PG8_LDB(B1, 0, 1); PG8_SCHED; PG8_LDA(At, 0, 0); PG8_STAGE(PG8_SA(1, 1), a1 + hstepA, voffA);
            PG8_WAIT_V(8); PG8_WAIT_L(0); PG8_BAR; PG8_MMA(0, 0, At, B0); PG8_MMA(0, 1, At, B1); PG8_BAR; PG8_SCHED;
            PG8_LDA(At, 0, 1); PG8_STAGE(PG8_SB(0, 0), b2, voffB); PG8_STAGE(PG8_SB(0, 1), b2 + hstepB, voffB); PG8_STAGE(PG8_SA(0, 0), a2, voffA);
            PG8_WAIT_V(8); PG8_WAIT_L(0); PG8_BAR; PG8_MMA(1, 0, At, B0); PG8_MMA(1, 1, At, B1); PG8_BAR; PG8_SCHED;
            PG8_LDB(B0, 1, 0); PG8_LDB(B1, 1, 1); PG8_SCHED; PG8_LDA(At, 1, 0); PG8_STAGE(PG8_SA(0, 1), a2 + hstepA, voffA);
            PG8_WAIT_V(8); PG8_WAIT_L(0); PG8_BAR; PG8_MMA(0, 0, At, B0); PG8_MMA(0, 1, At, B1); PG8_BAR; PG8_SCHED;
            PG8_LDA(At, 1, 1); PG8_STAGE(PG8_SB(1, 0), b3, voffB); PG8_STAGE(PG8_SB(1, 1), b3 + hstepB, voffB); PG8_STAGE(PG8_SA(1, 0), a3, voffA);
            PG8_WAIT_V(8); PG8_WAIT_L(0); PG8_BAR; PG8_MMA(1, 0, At, B0); PG8_MMA(1, 1, At, B1); PG8_BAR; PG8_SCHED;
            } else {
            PG8_LDB(B0, 0, 0); PG8_SCHED; PG8_LDA(At, 0, 0); PG8_STAGE(PG8_SA(1, 1), a1 + hstepA, voffA);
            PG8_WAIT_L(8); PG8_BAR; PG8_WAIT_L(0); PG8_MMA(0, 0, At, B0); PG8_BAR; PG8_SCHED;
            PG8_LDB(B1, 0, 1); PG8_STAGE(PG8_SB(0, 0), b2, voffB);
            PG8_BAR; PG8_WAIT_L(0); PG8_MMA(0, 1, At, B1); PG8_BAR;
            PG8_LDA(At, 0, 1); PG8_STAGE(PG8_SA(0, 0), a2, voffA);
            PG8_BAR; PG8_WAIT_L(0); PG8_MMA(1, 0, At, B0); PG8_BAR; PG8_SCHED;
            PG8_STAGE(PG8_SB(0, 1), b2 + hstepB, voffB);
            PG8_WAIT_V(6); PG8_BAR; PG8_MMA(1, 1, At, B1); PG8_BAR;
            PG8_LDB(B0, 1, 0); PG8_SCHED; PG8_LDA(At, 1, 0); PG8_STAGE(PG8_SA(0, 1), a2 + hstepA, voffA);
            PG8_WAIT_L(8); PG8_BAR; PG8_WAIT_L(0); PG8_MMA(0, 0, At, B0); PG8_BAR; PG8_SCHED;
            PG8_LDB(B1, 1, 1); PG8_STAGE(PG8_SB(1, 0), b3, voffB);
            PG8_BAR; PG8_WAIT_L(0); PG8_MMA(0, 1, At, B1); PG8_BAR;
            PG8_LDA(At, 1, 1); PG8_STAGE(PG8_SA(1, 0), a3, voffA);
            PG8_BAR; PG8_WAIT_L(0); PG8_MMA(1, 0, At, B0); PG8_BAR; PG8_SCHED;
            PG8_STAGE(PG8_SB(1, 1), b3 + hstepB, voffB);
            PG8_WAIT_V(6); PG8_BAR; PG8_MMA(1, 1, At, B1); PG8_BAR;
            }
        }
        if constexpr (ALIGN_EPI) { if (wr == 0) PG8_BAR; }
        E(acc, cur, wr, wc, fr, fq);
        if (!has_next) break;
#pragma unroll
        for (int a = 0; a < 2; ++a)
#pragma unroll
            for (int b = 0; b < 2; ++b)
#pragma unroll
                for (int m = 0; m < 4; ++m)
#pragma unroll
                    for (int n = 0; n < 2; ++n) acc[a][b][m][n] = (f32x4){0.f, 0.f, 0.f, 0.f};
        cur = nxt; cA = nA; cB = nB; ++ui;
        if constexpr (ALIGN_EPI) { if (wr == 1) PG8_BAR; }
    }
    PG8_WAIT_V(0);
    if constexpr (!ALIGN_EPI) { if (wr == 0) PG8_BAR; }
    PG8_BAR;
#undef PG8_SA
#undef PG8_SB
#undef PG8_STAGE
#undef PG8_LDA
#undef PG8_LDB
#undef PG8_MMA
#undef PG8_WAIT_V
#undef PG8_WAIT_L
#undef PG8_BAR
#undef PG8_SCHED
#undef PG8_TA
#undef PG8_TB
}
}

namespace att {
using bf16 = __hip_bfloat16;
constexpr int   D = 128, NW = 8, QBLK = 32, KVBLK = 64;
constexpr float SCALE = 0.088388347648318440f;
constexpr float THR = 8.f;
constexpr int LDQ = 8192, LDK = 8192, LDO = 8192;
constexpr size_t SHM_V = KVBLK * D * 2, SHM_K = KVBLK * D * 2, SHM_ATTN = 2 * SHM_V + 2 * SHM_K + NW * 64 * 4;
using bf16x8 = __attribute__((ext_vector_type(8))) short;
using s16x4  = __attribute__((ext_vector_type(4))) short;
using f32x16 = __attribute__((ext_vector_type(16))) float;
using u32x4  = __attribute__((ext_vector_type(4))) unsigned;
#define KSWZ(row, colB) ((row) * 256 + ((colB) ^ (((row) & 7) << 4)))
#define SBAR() __builtin_amdgcn_sched_barrier(0)
__device__ __forceinline__ int crow(int r, int hi) { return (r & 3) + 8 * (r >> 2) + 4 * hi; }
__device__ __forceinline__ unsigned cvtpk(float lo, float hi) { unsigned r; asm volatile("v_cvt_pk_bf16_f32 %0, %1, %2" : "=v"(r) : "v"(lo), "v"(hi)); return r; }
__device__ __forceinline__ bf16x8 ld8(const bf16* p) { return *reinterpret_cast<const bf16x8*>(p); }

__device__ __forceinline__ void partialSM(f32x16& p0, f32x16& p1, float& m_reg, float& mn, float& alpha) {
  constexpr float C = SCALE * 1.4426950408889634f;
  float pmax = p0[0]; for (int r = 1; r < 16; ++r) pmax = fmaxf(pmax, p0[r]); for (int r = 0; r < 16; ++r) pmax = fmaxf(pmax, p1[r]);
  { auto rr = __builtin_amdgcn_permlane32_swap(__float_as_uint(pmax), __float_as_uint(pmax), false, false);
    pmax = fmaxf(__uint_as_float(rr[0]), __uint_as_float(rr[1])); }
  if (__builtin_expect(__all(pmax - m_reg <= THR / SCALE), 1)) { mn = m_reg; alpha = 1.f; }
  else { mn = fmaxf(m_reg, pmax); alpha = __builtin_amdgcn_exp2f((m_reg - mn) * C); m_reg = mn; }
  float mnC = -mn * C;
  for (int r = 0; r < 16; ++r) p0[r] = fmaf(p0[r], C, mnC); for (int r = 0; r < 16; ++r) p1[r] = fmaf(p1[r], C, mnC);
  for (int r = 0; r < 16; ++r) p0[r] = __builtin_amdgcn_exp2f(p0[r]);
}
__device__ __forceinline__ void finishSM(f32x16& p0, f32x16& p1, float alpha, float& l_reg, bf16x8& pa0, bf16x8& pa1, bf16x8& pa2, bf16x8& pa3) {
  for (int r = 0; r < 16; ++r) p1[r] = __builtin_amdgcn_exp2f(p1[r]);
  float ps = 0; for (int r = 0; r < 16; ++r) ps += p0[r]; for (int r = 0; r < 16; ++r) ps += p1[r];
  { auto rr = __builtin_amdgcn_permlane32_swap(__float_as_uint(ps), __float_as_uint(ps), false, false);
    ps = __uint_as_float(rr[0]) + __uint_as_float(rr[1]); }
  l_reg = l_reg * alpha + ps;
#define PK4(P, BASE, OUT) do { unsigned a0 = cvtpk(P[BASE + 0], P[BASE + 1]), a1 = cvtpk(P[BASE + 2], P[BASE + 3]);   \
    unsigned b0 = cvtpk(P[BASE + 4], P[BASE + 5]), b1 = cvtpk(P[BASE + 6], P[BASE + 7]);                              \
    auto r0 = __builtin_amdgcn_permlane32_swap(a0, b0, false, false); auto r1 = __builtin_amdgcn_permlane32_swap(a1, b1, false, false); \
    u32x4 w = {r0[0], r1[0], r0[1], r1[1]}; OUT = *reinterpret_cast<bf16x8*>(&w); } while (0)
  PK4(p0, 0, pa0); PK4(p0, 8, pa1); PK4(p1, 0, pa2); PK4(p1, 8, pa3);
#undef PK4
}
__device__ __forceinline__ void qkt(f32x16& p0, f32x16& p1, const bf16* Ks, const bf16x8* qr, int r32, int hi) {
  p0 = f32x16{}; p1 = f32x16{};
  for (int d0 = 0; d0 < 8; ++d0) { int cb = (d0 * 16 + hi * 8) * 2;
    bf16x8 b0 = *reinterpret_cast<const bf16x8*>((const char*)Ks + KSWZ(r32, cb));
    bf16x8 b1 = *reinterpret_cast<const bf16x8*>((const char*)Ks + KSWZ(32 + r32, cb));
    p0 = __builtin_amdgcn_mfma_f32_32x32x16_bf16(b0, qr[d0], p0, 0, 0, 0);
    p1 = __builtin_amdgcn_mfma_f32_32x32x16_bf16(b1, qr[d0], p1, 0, 0, 0); }
}
__device__ __forceinline__ int v_st(int k, int c) { const int kk = (k & ~0xC) | ((k & 4) << 1) | ((k & 8) >> 1); return ((kk >> 3) * 4 + (c >> 5)) * 512 + ((kk & 7) * 32 + (c & 31)) * 2; }
__device__ __forceinline__ int v_rd_base(int lane) { return ((lane & 3) << 3) | (((lane >> 2) & 3) << 6) | (((lane >> 4) & 1) << 5) | (((lane >> 5) & 1) << 8); }
constexpr int v_rd_off(int d0, int ks, int half) { return d0 * 512 + ks * 4096 + half * 2048; }
template <int OFF> __device__ __forceinline__ s16x4 tr_read(int vb) {
  s16x4 r; asm volatile("ds_read_b64_tr_b16 %0, %1 offset:%2" : "=&v"(r) : "v"(vb), "i"(OFF) : "memory"); return r;
}
template <int D0> __device__ __forceinline__ void pv_one(f32x16& od, int vb, bf16x8 pa0, bf16x8 pa1, bf16x8 pa2, bf16x8 pa3) {
  const s16x4 l0 = tr_read<v_rd_off(D0, 0, 0)>(vb), h0 = tr_read<v_rd_off(D0, 0, 1)>(vb), l1 = tr_read<v_rd_off(D0, 1, 0)>(vb), h1 = tr_read<v_rd_off(D0, 1, 1)>(vb);
  const s16x4 l2 = tr_read<v_rd_off(D0, 2, 0)>(vb), h2 = tr_read<v_rd_off(D0, 2, 1)>(vb), l3 = tr_read<v_rd_off(D0, 3, 0)>(vb), h3 = tr_read<v_rd_off(D0, 3, 1)>(vb);
  asm volatile("s_waitcnt lgkmcnt(0)" ::: "memory"); SBAR();
#define PK(L, H) (bf16x8){L[0], L[1], L[2], L[3], H[0], H[1], H[2], H[3]}
  od = __builtin_amdgcn_mfma_f32_32x32x16_bf16(pa0, PK(l0, h0), od, 0, 0, 0);
  od = __builtin_amdgcn_mfma_f32_32x32x16_bf16(pa1, PK(l1, h1), od, 0, 0, 0);
  od = __builtin_amdgcn_mfma_f32_32x32x16_bf16(pa2, PK(l2, h2), od, 0, 0, 0);
  od = __builtin_amdgcn_mfma_f32_32x32x16_bf16(pa3, PK(l3, h3), od, 0, 0, 0);
#undef PK
}
__device__ __forceinline__ void pv_d0(f32x16* o, int vb, bf16x8 pa0, bf16x8 pa1, bf16x8 pa2, bf16x8 pa3) {
  pv_one<0>(o[0], vb, pa0, pa1, pa2, pa3); pv_one<1>(o[1], vb, pa0, pa1, pa2, pa3); pv_one<2>(o[2], vb, pa0, pa1, pa2, pa3); pv_one<3>(o[3], vb, pa0, pa1, pa2, pa3);
}

__device__ __forceinline__ void attn_dense_body(const bf16* Qb, const bf16* __restrict__ Kh, const bf16* __restrict__ Vh,
                                                bf16* Ob, int seq, char* lds) {
  constexpr int SDEPTH = 2;
  const int tid = threadIdx.x, wid = tid >> 6, lane = tid & 63, r32 = lane & 31, hi = lane >> 5;
  bf16* V_lds = (bf16*)lds; bf16* K_lds = (bf16*)(lds + 2 * SHM_V);
  float* ws = (float*)(lds + 2 * SHM_V + 2 * SHM_K) + wid * 64; float* li_l = ws; float* al_l = ws + 32;
  float m_reg = -1e30f, l_reg = 0; f32x16 o[4] = {}; bf16x8 qr[8];
  const bf16* Qw = Qb + (long)(wid * QBLK + r32) * LDQ + hi * 8;
#pragma unroll
  for (int d0 = 0; d0 < 8; ++d0) qr[d0] = ld8(Qw + d0 * 16);
  const int sr = tid >> 4, sc = (tid & 15) * 8, vst0 = v_st(sr, sc), vst1 = v_st(32 + sr, sc);
  const int vb0 = (int)(uintptr_t)V_lds + v_rd_base(lane);
  struct { bf16x8 vs0, vs1, ks0, ks1; } sr_[SDEPTH];
#define SLOAD(i, k0) do { sr_[i].vs0 = ld8(&Vh[(long)((k0) + sr) * LDK + sc]); sr_[i].vs1 = ld8(&Vh[(long)((k0) + 32 + sr) * LDK + sc]); \
    sr_[i].ks0 = ld8(&Kh[(long)((k0) + sr) * LDK + sc]); sr_[i].ks1 = ld8(&Kh[(long)((k0) + 32 + sr) * LDK + sc]); } while (0)
#define SWRITE(b, i) do { *(bf16x8*)((char*)V_lds + (b) * SHM_V + vst0) = sr_[i].vs0;          \
    *(bf16x8*)((char*)V_lds + (b) * SHM_V + vst1) = sr_[i].vs1; int kc = sc * 2;               \
    *(bf16x8*)((char*)K_lds + (b) * SHM_K + KSWZ(sr, kc)) = sr_[i].ks0;                       \
    *(bf16x8*)((char*)K_lds + (b) * SHM_K + KSWZ(32 + sr, kc)) = sr_[i].ks1; } while (0)
#define SWAIT() do { asm volatile("s_waitcnt vmcnt(4)" ::: "memory"); } while (0)
#define RESC(a) do { if (__any((a) < 1.f)) { if (hi == 0) al_l[r32] = (a); asm volatile("s_waitcnt lgkmcnt(0)" ::: "memory"); \
    for (int d = 0; d < 4; ++d) for (int r = 0; r < 16; ++r) o[d][r] *= al_l[crow(r, hi)]; } } while (0)
  f32x16 pA0, pA1, pB0, pB1; float mnA, mnB, alA, alB; bf16x8 pa0, pa1, pa2, pa3; const int NT = seq / KVBLK;
  constexpr int SE = 0, SO = SDEPTH - 1;
  SLOAD(SE, 0); asm volatile("s_waitcnt vmcnt(0)" ::: "memory"); SWRITE(0, SE); __syncthreads();
  qkt(pA0, pA1, K_lds, qr, r32, hi); partialSM(pA0, pA1, m_reg, mnA, alA);
  SLOAD(SO, KVBLK); if (2 < NT) SLOAD(SE, 2 * KVBLK);
  SWAIT(); SWRITE(1, SO); __syncthreads();
  for (int j = 1; j + 1 < NT; j += 2) {
    SBAR(); qkt(pB0, pB1, (bf16*)((char*)K_lds + SHM_K), qr, r32, hi);
    finishSM(pA0, pA1, alA, l_reg, pa0, pa1, pa2, pa3); SBAR();
    SLOAD(SO, (j + SDEPTH) * KVBLK); SBAR();
    pv_d0(o, vb0, pa0, pa1, pa2, pa3); partialSM(pB0, pB1, m_reg, mnB, alB);
    __syncthreads(); SWAIT(); SWRITE(0, SE);
    RESC(alB); __syncthreads();
    SBAR(); qkt(pA0, pA1, K_lds, qr, r32, hi);
    finishSM(pB0, pB1, alB, l_reg, pa0, pa1, pa2, pa3); SBAR();
    if (j + 3 < NT) SLOAD(SE, (j + 1 + SDEPTH) * KVBLK); SBAR();
    pv_d0(o, vb0 + (int)SHM_V, pa0, pa1, pa2, pa3); partialSM(pA0, pA1, m_reg, mnA, alA);
    __syncthreads(); SWAIT(); SWRITE(1, SO);
    RESC(alA); __syncthreads();
  }
  SBAR(); qkt(pB0, pB1, (bf16*)((char*)K_lds + SHM_K), qr, r32, hi);
  finishSM(pA0, pA1, alA, l_reg, pa0, pa1, pa2, pa3); SBAR();
  pv_d0(o, vb0, pa0, pa1, pa2, pa3); partialSM(pB0, pB1, m_reg, mnB, alB);
  __syncthreads(); RESC(alB);
  finishSM(pB0, pB1, alB, l_reg, pa0, pa1, pa2, pa3); SBAR();
  pv_d0(o, vb0 + (int)SHM_V, pa0, pa1, pa2, pa3);
  if (hi == 0) li_l[r32] = l_reg; asm volatile("s_waitcnt lgkmcnt(0)" ::: "memory");
  float rli[16];
#pragma unroll
  for (int r = 0; r < 16; ++r) rli[r] = __builtin_amdgcn_rcpf(li_l[crow(r, hi)]);
  unsigned short* Ow = (unsigned short*)Ob + (long)(wid * QBLK) * LDO;
#pragma unroll
  for (int r = 0; r < 16; ++r) { int orow = crow(r, hi);
#pragma unroll
    for (int d0 = 0; d0 < 4; ++d0) Ow[(long)orow * LDO + d0 * 32 + r32] = (unsigned short)(cvtpk(o[d0][r] * rli[r], 0.f) & 0xffffu); }
#undef SLOAD
#undef SWRITE
#undef SWAIT
#undef RESC
}
}

constexpr int S_ = 16384, DM = 2048, FF = 5632, INW = 8192;
constexpr float EPS = 1e-6f;
constexpr size_t MiB = 1u << 20;
constexpr size_t WS_G1 = 0;
constexpr size_t WS_TW = 256 * 1024;
constexpr size_t WS_W = 1 * MiB;
constexpr size_t WS_WGU = WS_W, WS_WD = WS_W + 44 * MiB;
constexpr size_t WS_WIN = WS_W, WS_WAO = WS_W + 32 * MiB, WS_WF = WS_W + 40 * MiB, WS_WOUT = WS_W + 44 * MiB;
constexpr size_t WS_U = 68 * MiB;
constexpr size_t WS_T = 132 * MiB;
constexpr size_t WS_R1 = 196 * MiB;
constexpr size_t WS_END = 452 * MiB;
constexpr int LDS_BYTES = 147456;
constexpr int NPHASE = 16;

typedef float f32x4 __attribute__((ext_vector_type(4)));
typedef unsigned u32x4 __attribute__((ext_vector_type(4)));
typedef unsigned u32x2 __attribute__((ext_vector_type(2)));
#define LAS __attribute__((address_space(3)))
#define LDS_WAIT() asm volatile("s_waitcnt lgkmcnt(0)" ::: "memory")

__device__ __forceinline__ float wave_sum(float v) {
#pragma unroll
    for (int o = 1; o < 64; o <<= 1) v += __shfl_xor(v, o);
    return v;
}
using pg8::cvt_pk_bf16; using pg8::bf_lo; using pg8::bf_hi;

__device__ __forceinline__ void transpose_item(const float* __restrict__ W, int N, unsigned short* __restrict__ WT, int ldt, int k0, int n0, int drow0, LAS float* scr, int lane) {
#pragma unroll 8
    for (int i = 0; i < 32; ++i) { const int kk = 2 * i + (lane >> 5); scr[kk * 33 + (lane & 31)] = W[(size_t)(k0 + kk) * N + n0 + (lane & 31)]; }
    LDS_WAIT(); asm volatile("" ::: "memory");
    const int c = lane & 7;
#pragma unroll
    for (int j = 0; j < 4; ++j) { const int n = (lane >> 3) + 8 * j; const LAS float* s = scr + (8 * c) * 33 + n;
        u32x4 o; o.x = cvt_pk_bf16(s[0 * 33], s[1 * 33]); o.y = cvt_pk_bf16(s[2 * 33], s[3 * 33]); o.z = cvt_pk_bf16(s[4 * 33], s[5 * 33]); o.w = cvt_pk_bf16(s[6 * 33], s[7 * 33]);
        *(u32x4*)(WT + (size_t)(drow0 + n) * ldt + k0 + 8 * c) = o; }
    LDS_WAIT(); asm volatile("" ::: "memory");
}
__device__ __forceinline__ void transpose_plain(const float* W, int K, int N, unsigned short* WT, int it, LAS float* scr, int lane) {
    const int nblk = N / 32, kb = it / nblk, nb = it % nblk;
    transpose_item(W, N, WT, K, 64 * kb, 32 * nb, 32 * nb, scr, lane);
}
__device__ __forceinline__ void convert_ffn(const float* Wg, const float* Wu, const float* Wd, unsigned short* WGU, unsigned short* WD, LAS float* scr, int gw, int NGW, int lane) {
    constexpr int I_G = (DM / 64) * (FF / 32), I_D = (FF / 64) * (DM / 32);
    for (int it = gw; it < 2 * I_G + I_D; it += NGW) {
        int r = it;
        if (r < 2 * I_G) { const bool up = r >= I_G; if (up) r -= I_G; const int nblk = FF / 32, kb = r / nblk, nb = r % nblk, n0 = 32 * nb;
            transpose_item(up ? Wu : Wg, FF, WGU, DM, 64 * kb, n0, (n0 >> 7) * 256 + (up ? 128 : 0) + (n0 & 127), scr, lane); continue; }
        r -= 2 * I_G; transpose_plain(Wd, FF, DM, WD, r, scr, lane);
    }
}
__device__ __forceinline__ void norm_row(const float* xrow, const float* g, unsigned short* orow, int lane) {
    const f32x4* xr = (const f32x4*)xrow + lane; const f32x4* gr = (const f32x4*)g + lane;
    f32x4 v[8]; float s = 0.f;
#pragma unroll
    for (int j = 0; j < 8; ++j) { v[j] = xr[64 * j]; s += (v[j].x * v[j].x + v[j].y * v[j].y) + (v[j].z * v[j].z + v[j].w * v[j].w); }
    const float rstd = 1.0f / sqrtf(wave_sum(s) * (1.f / DM) + EPS);
    u32x2* o8 = (u32x2*)orow + lane;
#pragma unroll
    for (int j = 0; j < 8; ++j) { const f32x4 gv = gr[64 * j]; u32x2 w; w.x = cvt_pk_bf16(v[j].x * rstd * gv.x, v[j].y * rstd * gv.y); w.y = cvt_pk_bf16(v[j].z * rstd * gv.z, v[j].w * rstd * gv.w); o8[64 * j] = w; }
}
template <bool NEXT>
__device__ __forceinline__ void res_norm_row(const unsigned short* trow, const float* brow, const float* post_g, float wgt, float* orow, const float* pre_g, unsigned short* urow, int lane) {
    const u32x2* tr = (const u32x2*)trow + lane;
    f32x4 t[8]; float s = 0.f;
#pragma unroll
    for (int j = 0; j < 8; ++j) { const u32x2 w = tr[64 * j]; t[j] = (f32x4){bf_lo(w.x), bf_hi(w.x), bf_lo(w.y), bf_hi(w.y)}; s += (t[j].x * t[j].x + t[j].y * t[j].y) + (t[j].z * t[j].z + t[j].w * t[j].w); }
    const float rstd = wgt / sqrtf(wave_sum(s) * (1.f / DM) + EPS);
    float s2 = 0.f;
#pragma unroll
    for (int j = 0; j < 8; ++j) { const f32x4 b = ((const f32x4*)brow + lane)[64 * j]; const f32x4 g = ((const f32x4*)post_g + lane)[64 * j];
        t[j] = b + t[j] * rstd * g; ((f32x4*)orow + lane)[64 * j] = t[j]; s2 += (t[j].x * t[j].x + t[j].y * t[j].y) + (t[j].z * t[j].z + t[j].w * t[j].w); }
    if (NEXT) {
        const float r2 = 1.0f / sqrtf(wave_sum(s2) * (1.f / DM) + EPS);
        u32x2* o8 = (u32x2*)urow + lane;
#pragma unroll
        for (int j = 0; j < 8; ++j) { const f32x4 gv = ((const f32x4*)pre_g + lane)[64 * j]; u32x2 w; w.x = cvt_pk_bf16(t[j].x * r2 * gv.x, t[j].y * r2 * gv.y); w.y = cvt_pk_bf16(t[j].z * r2 * gv.z, t[j].w * r2 * gv.w); o8[64 * j] = w; }
    }
}
__device__ __forceinline__ void qk_rope_row(unsigned short* row, int s, const float* qg, const float* kg, int lane) {
    const int sec = lane >> 5, half = (lane >> 4) & 1, i0 = (2 * lane) & 31;
    const float pos = (float)(sec == 0 ? (s >> 6) : (s & 63));
    const float L = 13.287712379549449f / 32.f;
    float cs[2], sn[2];
#pragma unroll
    for (int e = 0; e < 2; ++e) { const float fr = exp2f(-(float)(i0 + e) * L); float rev = pos * fr * 0.15915494309189535f; rev -= floorf(rev);
        sn[e] = __builtin_amdgcn_sinf(rev); cs[e] = __builtin_amdgcn_cosf(rev); }
    const float gq0 = qg[2 * lane], gq1 = qg[2 * lane + 1], gk0 = kg[2 * lane], gk1 = kg[2 * lane + 1];
    unsigned w[20];
#pragma unroll
    for (int h = 0; h < 20; ++h) w[h] = ((const unsigned*)(row + h * 128))[lane];
#pragma unroll
    for (int h = 0; h < 20; ++h) {
        const float x0 = bf_lo(w[h]), x1 = bf_hi(w[h]);
        const float rstd = 1.0f / sqrtf(wave_sum(x0 * x0 + x1 * x1) * (1.f / 128.f) + EPS);
        const float y0 = x0 * rstd * (h < 16 ? gq0 : gk0), y1 = x1 * rstd * (h < 16 ? gq1 : gk1);
        const float p0 = __shfl_xor(y0, 16), p1 = __shfl_xor(y1, 16);
        const float o0 = half ? (y0 * cs[0] + p0 * sn[0]) : (y0 * cs[0] - p0 * sn[0]);
        const float o1 = half ? (y1 * cs[1] + p1 * sn[1]) : (y1 * cs[1] - p1 * sn[1]);
        ((unsigned*)(row + h * 128))[lane] = cvt_pk_bf16(o0, o1);
    }
}

#define SINGLE_ARG(...) __VA_ARGS__
struct Args { const float* in[20]; float* out; unsigned char* ws; int ph_lo, ph_hi; };

__global__ void __launch_bounds__(512, 2) mk_fwd(Args args) {
    extern __shared__ __attribute__((aligned(16))) unsigned char lds[];
    cg::grid_group grid = cg::this_grid();
    const int tid = threadIdx.x, lane = tid & 63, wave = __builtin_amdgcn_readfirstlane(tid >> 6);
    const int G = gridDim.x, bx = blockIdx.x;
    const int gw = bx * 8 + wave, NGW = G * 8;
    unsigned char* ws = args.ws;
    unsigned short* const G1 = (unsigned short*)(ws + WS_G1); float* const TW = (float*)(ws + WS_TW);
    unsigned short* const U = (unsigned short*)(ws + WS_U); unsigned short* const T = (unsigned short*)(ws + WS_T); unsigned short* const R1 = (unsigned short*)(ws + WS_R1);
    const float* x = args.in[0]; float* out = args.out;
    LAS unsigned char* ldsl = (LAS unsigned char*)lds;
    LAS float* scr = (LAS float*)(ldsl + wave * 16384);
    const int lo = args.ph_lo, hi = args.ph_hi;
#ifndef F1_AL
#define F1_AL false
#endif
#ifndef F1_SP
#define F1_SP true
#endif
#ifndef PHASE_MASK
#define PHASE_MASK 0xFFFF
#endif
#define IN(k) (((PHASE_MASK >> (k)) & 1) && lo <= (k) && (k) < hi)
#define SEAM(k) do { if (IN(k) && IN((k) + 1)) grid.sync(); } while (0)
#define GEMM_PHASE_X(CFG, EPI, AL, SP, Aptr, Bptr, M_, N_, ...) do { pg8::Gemm g_{(const char*)(Aptr), (const char*)(Bptr)}; pg8::StaticOrder So_; So_.init((M_), (N_), G, bx); \
        EPI E_{__VA_ARGS__}; pg8::gemm_phase<CFG, EPI, pg8::StaticOrder, AL, SP>(ldsl, g_, So_, E_); } while (0)
#define GEMM_PHASE(CFG, EPI, ...) GEMM_PHASE_X(SINGLE_ARG(CFG), SINGLE_ARG(EPI), true, true, __VA_ARGS__)
    typedef pg8::Cfg<512u, (unsigned)(128 * INW * 2), (size_t)128 * 512, (size_t)INW * 2, 0, 0, 256, (size_t)2 * INW * 2, 128> CfgF1;
    typedef pg8::Cfg<512u, 512u, (size_t)128 * 512, (size_t)128 * 512, 0, 0, 0, (size_t)256 * 512, 256> CfgF2;

    if (IN(0)) {
        convert_ffn(args.in[2], args.in[3], args.in[4], (unsigned short*)(ws + WS_WGU), (unsigned short*)(ws + WS_WD), scr, gw, NGW, lane);
        for (int e = bx * 512 + tid; e < 256 * 256; e += G * 512) { const int r = e >> 8, c = e & 255, ro = r >> 7, i = r & 127, ri = c >> 7, j = c & 127, a = (i * j) & 127;
            const float cv = cospif((float)a * (1.f / 64.f)), sv = sinpif((float)a * (1.f / 64.f));
            const float v = (ro == ri) ? cv : (ro == 0 ? sv : -sv);
            G1[e] = (unsigned short)(cvt_pk_bf16(v * 0.08838834764831845f, 0.f) & 0xffffu); }
        for (int e = bx * 512 + tid; e < 128 * 128; e += G * 512) { const int c = e >> 7, b = e & 127, a = (b * c) & 16383;
            TW[2 * e] = cospif((float)a * (1.f / 8192.f)); TW[2 * e + 1] = -sinpif((float)a * (1.f / 8192.f)); }
        for (int m = gw; m < S_; m += NGW) norm_row(x + (size_t)m * DM, args.in[1], U + (size_t)m * DM, lane);
    }
    SEAM(0);
    if (IN(1)) GEMM_PHASE(SINGLE_ARG(pg8::StdCfg<DM, DM, DM>), pg8::EpiSwiglu, U, ws + WS_WGU, S_, 2 * FF, R1, FF);
    SEAM(1);
    if (IN(2)) GEMM_PHASE(SINGLE_ARG(pg8::StdCfg<FF, FF, FF>), pg8::EpiStore, R1, ws + WS_WD, S_, DM, T, DM);
    SEAM(2);
    if (IN(3)) {
        for (int m = gw; m < S_; m += NGW) res_norm_row<true>(T + (size_t)m * DM, x + (size_t)m * DM, args.in[5], 0.5f, out + (size_t)m * DM, args.in[6], U + (size_t)m * DM, lane);
        constexpr int I_IN = (DM / 64) * (INW / 32), I_AO = (DM / 64) * (DM / 32), I_F = (1024 / 64) * (DM / 32);
        for (int it = gw; it < I_IN + 2 * I_AO + I_F; it += NGW) { int r = it;
            if (r < I_IN) { transpose_plain(args.in[7], DM, INW, (unsigned short*)(ws + WS_WIN), r, scr, lane); continue; } r -= I_IN;
            if (r < I_AO) { transpose_plain(args.in[11], DM, DM, (unsigned short*)(ws + WS_WAO), r, scr, lane); continue; } r -= I_AO;
            if (r < I_F) { transpose_plain(args.in[12], 1024, DM, (unsigned short*)(ws + WS_WF), r, scr, lane); continue; } r -= I_F;
            transpose_plain(args.in[13], DM, DM, (unsigned short*)(ws + WS_WOUT), r, scr, lane); }
    }
    SEAM(3);
    if (IN(4)) GEMM_PHASE(SINGLE_ARG(pg8::StdCfg<DM, DM, DM>), pg8::EpiStore, U, ws + WS_WIN, S_, INW, R1, INW);
    SEAM(4);
    if (IN(5)) {
        for (int m = gw; m < S_; m += NGW) qk_rope_row(R1 + (size_t)m * INW, m, args.in[9], args.in[10], lane);
        GEMM_PHASE_X(CfgF1, pg8::EpiZt, F1_AL, F1_SP, G1, R1 + 3072, 8 * 256, 64 * 256, U);
    }
    SEAM(5);
    if (IN(6)) GEMM_PHASE(CfgF2, pg8::EpiYt, G1, U, 256, 131072, T, TW);
    SEAM(6);
    if (IN(7)) GEMM_PHASE(CfgF2, pg8::EpiXf, G1, T, 256, 131072, R1 + 3072, INW);
    SEAM(7);
    if (IN(8)) {
        for (int u = bx; u < 1024; u += G) { const int kvh = u >> 8, w = u & 255, qh = 4 * kvh + (w & 3), qb = w >> 2;
            const att::bf16* base = (const att::bf16*)R1;
            __syncthreads();
            att::attn_dense_body(base + (size_t)qb * 256 * INW + qh * 128, base + 2048 + kvh * 128, base + 2560 + kvh * 128,
                                 (att::bf16*)R1 + (size_t)qb * 256 * INW + qh * 128, S_, (char*)lds);
        }
        __syncthreads();
    }
    SEAM(8);
    if (IN(9)) GEMM_PHASE(SINGLE_ARG(pg8::StdCfg<INW, DM, DM>), pg8::EpiGate<false>, R1, ws + WS_WAO, S_, DM, U, DM, R1 + 4096, INW, args.in[8]);
    SEAM(9);
    if (IN(10)) GEMM_PHASE(SINGLE_ARG(pg8::StdCfg<INW, 1024, 1024>), pg8::EpiGate<true>, R1 + 3072, ws + WS_WF, S_, DM, U, DM, R1 + 4096 + DM, INW, args.in[8] + DM);
    SEAM(10);
    if (IN(11)) GEMM_PHASE(SINGLE_ARG(pg8::StdCfg<DM, DM, DM>), pg8::EpiStore, U, ws + WS_WOUT, S_, DM, T, DM);
    SEAM(11);
    if (IN(12)) {
        for (int m = gw; m < S_; m += NGW) res_norm_row<true>(T + (size_t)m * DM, out + (size_t)m * DM, args.in[14], 1.0f, out + (size_t)m * DM, args.in[15], U + (size_t)m * DM, lane);
        convert_ffn(args.in[16], args.in[17], args.in[18], (unsigned short*)(ws + WS_WGU), (unsigned short*)(ws + WS_WD), scr, gw, NGW, lane);
    }
    SEAM(12);
    if (IN(13)) GEMM_PHASE(SINGLE_ARG(pg8::StdCfg<DM, DM, DM>), pg8::EpiSwiglu, U, ws + WS_WGU, S_, 2 * FF, R1, FF);
    SEAM(13);
    if (IN(14)) GEMM_PHASE(SINGLE_ARG(pg8::StdCfg<FF, FF, FF>), pg8::EpiStore, R1, ws + WS_WD, S_, DM, T, DM);
    SEAM(14);
    if (IN(15)) {
        for (int m = gw; m < S_; m += NGW) res_norm_row<false>(T + (size_t)m * DM, out + (size_t)m * DM, args.in[19], 0.5f, out + (size_t)m * DM, nullptr, nullptr, lane);
    }
#undef IN
#undef SEAM
#undef GEMM_PHASE
#undef GEMM_PHASE_X
}

extern "C" void kernel_launch(void* const* d_in, const int* in_sizes, int n_in, void* d_out, int out_size, void* d_ws, size_t ws_size, hipStream_t stream) {
    static int grid = 0;
    if (grid == 0) {
        if (n_in != 20 || in_sizes[0] != S_ * DM || out_size != S_ * DM || ws_size < WS_END) {
            fprintf(stderr, "kernel_launch: shape/workspace mismatch: n_in %d in0 %d out %d ws %zu (need %zu)\n", n_in, n_in > 0 ? in_sizes[0] : -1, out_size, ws_size, (size_t)WS_END); grid = -1; return; }
        int dev = 0, cus = 0, per_cu = 0;
        if (hipGetDevice(&dev) != hipSuccess || hipDeviceGetAttribute(&cus, hipDeviceAttributeMultiprocessorCount, dev) != hipSuccess) { fprintf(stderr, "kernel_launch: device query failed\n"); grid = -1; return; }
        if (hipFuncSetAttribute((const void*)mk_fwd, hipFuncAttributeMaxDynamicSharedMemorySize, LDS_BYTES) != hipSuccess) { fprintf(stderr, "kernel_launch: hipFuncSetAttribute failed\n"); grid = -1; return; }
        if (hipOccupancyMaxActiveBlocksPerMultiprocessor(&per_cu, (const void*)mk_fwd, 512, LDS_BYTES) != hipSuccess || per_cu < 1) { fprintf(stderr, "kernel_launch: occupancy query says %d blocks per CU\n", per_cu); per_cu = 1; }
        (void)hipGetLastError();
        grid = cus;
    }
    if (grid < 0) return;
    Args a{};
    for (int i = 0; i < 20; ++i) a.in[i] = (const float*)d_in[i];
    a.out = (float*)d_out; a.ws = (unsigned char*)d_ws;
#if MK_PER_PHASE
    for (int p = 0; p < NPHASE; ++p) { a.ph_lo = p; a.ph_hi = p + 1;
        hipLaunchKernelGGL(mk_fwd, dim3(grid), dim3(512), LDS_BYTES, stream, a);
        const hipError_t le = hipPeekAtLastError(); if (le != hipSuccess) { fprintf(stderr, "kernel_launch: launch %d failed: %s\n", p, hipGetErrorName(le)); break; } }
#else
    a.ph_lo = 0; a.ph_hi = NPHASE;
    void* kargs[] = {&a};
    const hipError_t e = hipLaunchCooperativeKernel((const void*)mk_fwd, dim3(grid), dim3(512), kargs, LDS_BYTES, stream);
    if (e != hipSuccess) fprintf(stderr, "kernel_launch: cooperative launch failed: %s (grid %d)\n", hipGetErrorString(e), grid);
#endif
}
```

```cpp
#include <hip/hip_runtime.h>
#include <hip/hip_bf16.h>
#include <hip/hip_cooperative_groups.h>
#include <cstdio>
#include <cstdint>
namespace cg = cooperative_groups;

#ifndef REP_GEMM
#define REP_GEMM 1
#endif
#ifndef REP_ATTN
#define REP_ATTN 1
#endif
#ifndef REP_F1
#define REP_F1 1
#endif
#ifndef REP_ROW
#define REP_ROW 1
#endif
#ifndef REP_ROPE
#define REP_ROPE 1
#endif
#ifndef REP_CONV
#define REP_CONV 1
#endif
#ifndef PROBE_TS
#define PROBE_TS 0
#endif
#ifndef PROBE_M1
#define PROBE_M1 0x0100
#endif
#ifndef PROBE_M2
#define PROBE_M2 0xFFFF
#endif
#ifndef MK_PER_PHASE
#define MK_PER_PHASE 0
#endif

namespace pg8 {
#define PG8_LAS __attribute__((address_space(3)))
typedef unsigned short bf16_t;
typedef short bf16x8 __attribute__((ext_vector_type(8)));
typedef float f32x4 __attribute__((ext_vector_type(4)));
typedef unsigned u32x4 __attribute__((ext_vector_type(4)));
constexpr int BM = 256, BK = 64, HALF = 128, HTB = HALF * BK * 2, STAGE_BYTES = 8 * HTB, NXCD = 8, WGM = 8;

__host__ __device__ __forceinline__ int lds_byte(int r, int c) { const int st = (r >> 4) * 2 + (c >> 5), rr = r & 15, cc = c & 31, ob = rr * 64 + cc * 2; return st * 1024 + (ob ^ (((ob >> 9) & 1) << 5)); }
__host__ __device__ __forceinline__ void stage_rc(int b, int& R, int& C) { const int st = b / 1024, sb = b % 1024, swz = sb ^ (((sb >> 9) & 1) << 5); R = (st >> 1) * 16 + swz / 64; C = (st & 1) * 32 + (swz % 64) / 2; }
__host__ __device__ __forceinline__ int perm32(int rho) { const int n = rho >> 4, i = rho & 15; return 8 * (i >> 2) + 4 * n + (i & 3); }

struct Unit { int pm, pn; };
struct Gemm { const char* A; const char* B; };
template <unsigned ROWA_, unsigned ROWB_, size_t HA_, size_t HB_, size_t PMA_, size_t PNA_, size_t PMB_, size_t PNB_, int K_> struct Cfg {
    static constexpr unsigned rowA = ROWA_, rowB = ROWB_; static constexpr size_t hstepA = HA_, hstepB = HB_, pmA = PMA_, pnA = PNA_, pmB = PMB_, pnB = PNB_; static constexpr int K = K_; };
template <int LDA, int LDB, int K_> using StdCfg = Cfg<(unsigned)LDA * 2u, (unsigned)LDB * 2u, (size_t)128 * LDA * 2, (size_t)128 * LDB * 2, (size_t)256 * LDA * 2, 0, 0, (size_t)256 * LDB * 2, K_>;

struct StaticOrder {
    int nM, nN, nwg, G, c, rep, wgm;
    __host__ __device__ void init(int M, int N, int G_, int c_, int rep_ = 1) { nM = M / BM; nN = N / BM; nwg = nM * nN; G = G_; c = c_; rep = rep_; wgm = (nN <= 8) ? 4 : WGM; }
    __host__ __device__ bool next(int i, Unit& u) const {
        long L = (long)i * G + c; if (L >= (long)nwg * rep) return false; L %= nwg;
        int wgid = (int)L; { const int q = nwg / NXCD, r = nwg % NXCD, xcd = wgid % NXCD, off = wgid / NXCD; wgid = (xcd < r ? xcd * (q + 1) : r * (q + 1) + (xcd - r) * q) + off; }
        const int nig = wgm * nN, gid = wgid / nig, fm = gid * wgm, gsz = (nM - fm) < wgm ? (nM - fm) : wgm;
        u.pm = fm + ((wgid % nig) % gsz); u.pn = (wgid % nig) / gsz; return true;
    }
};

__device__ __forceinline__ unsigned cvt_pk_bf16(float lo, float hi) { unsigned r; asm volatile("v_cvt_pk_bf16_f32 %0, %1, %2" : "=v"(r) : "v"(lo), "v"(hi)); return r; }
__device__ __forceinline__ float bf_lo(unsigned w) { return __uint_as_float(w << 16); }
__device__ __forceinline__ float bf_hi(unsigned w) { return __uint_as_float(w & 0xffff0000u); }
__device__ __forceinline__ u32x4 pack8(const f32x4 a, const f32x4 b) { u32x4 w; w.x = cvt_pk_bf16(a[0], a[1]); w.y = cvt_pk_bf16(a[2], a[3]); w.z = cvt_pk_bf16(b[0], b[1]); w.w = cvt_pk_bf16(b[2], b[3]); return w; }
__device__ __forceinline__ float sigmoidf_(float x) { return __builtin_amdgcn_rcpf(1.f + __builtin_amdgcn_exp2f(-1.4426950408889634f * x)); }


struct EpiStore {
    static constexpr bool PERM = true, IDEMPOTENT = true; static constexpr int REPX = 1;
    bf16_t* O; int ldc; int split = 1 << 30, gap = 0;
    __device__ __forceinline__ void operator()(const f32x4 (&acc)[2][2][4][2], const Unit& u, int wr, int wc, int fr, int fq) const {
        const int row0 = u.pm * BM + wr * 64 + fr, col0 = u.pn * BM + (u.pn >= split ? gap : 0) + wc * 32 + 8 * fq;
#pragma unroll
        for (int ai = 0; ai < 2; ++ai)
#pragma unroll
            for (int m = 0; m < 4; ++m) { bf16_t* rowp = O + (size_t)(row0 + ai * HALF + m * 16) * ldc + col0;
#pragma unroll
                for (int bj = 0; bj < 2; ++bj) *(u32x4*)(rowp + bj * HALF) = pack8(acc[ai][bj][m][0], acc[ai][bj][m][1]); }
    }
};
struct EpiSwiglu {
    static constexpr bool PERM = true, IDEMPOTENT = true; static constexpr int REPX = 1;
    bf16_t* O; int ldc;
    __device__ __forceinline__ void operator()(const f32x4 (&acc)[2][2][4][2], const Unit& u, int wr, int wc, int fr, int fq) const {
        const int row0 = u.pm * BM + wr * 64 + fr, col0 = u.pn * HALF + wc * 32 + 8 * fq;
#pragma unroll
        for (int ai = 0; ai < 2; ++ai)
#pragma unroll
            for (int m = 0; m < 4; ++m) { bf16_t* rowp = O + (size_t)(row0 + ai * HALF + m * 16) * ldc + col0;
                f32x4 v[2];
#pragma unroll
                for (int n = 0; n < 2; ++n) { const f32x4 g = acc[ai][0][m][n], up = acc[ai][1][m][n];
#pragma unroll
                    for (int j = 0; j < 4; ++j) v[n][j] = g[j] * sigmoidf_(g[j]) * up[j]; }
                *(u32x4*)rowp = pack8(v[0], v[1]); }
    }
};
template <bool ACCUM> struct EpiGate {
    static constexpr bool PERM = true, IDEMPOTENT = !ACCUM; static constexpr int REPX = 1;
    bf16_t* O; int ldc; const bf16_t* Gt; int ldg; const float* bias;
    __device__ __forceinline__ void operator()(const f32x4 (&acc)[2][2][4][2], const Unit& u, int wr, int wc, int fr, int fq) const {
        const int row0 = u.pm * BM + wr * 64 + fr, col0 = u.pn * BM + wc * 32 + 8 * fq;
        f32x4 bv[2][2];
#pragma unroll
        for (int bj = 0; bj < 2; ++bj)
#pragma unroll
            for (int n = 0; n < 2; ++n) bv[bj][n] = *(const f32x4*)(bias + col0 + bj * HALF + 4 * n);
#pragma unroll
        for (int ai = 0; ai < 2; ++ai)
#pragma unroll
            for (int m = 0; m < 4; ++m) { const size_t r = (size_t)(row0 + ai * HALF + m * 16);
#pragma unroll
                for (int bj = 0; bj < 2; ++bj) { const u32x4 gw = *(const u32x4*)(Gt + r * ldg + col0 + bj * HALF);
                    f32x4 g0 = {bf_lo(gw.x), bf_hi(gw.x), bf_lo(gw.y), bf_hi(gw.y)}, g1 = {bf_lo(gw.z), bf_hi(gw.z), bf_lo(gw.w), bf_hi(gw.w)};
                    g0 = g0 + bv[bj][0]; g1 = g1 + bv[bj][1];
                    f32x4 v0, v1;
#pragma unroll
                    for (int j = 0; j < 4; ++j) { v0[j] = sigmoidf_(g0[j]) * acc[ai][bj][m][0][j]; v1[j] = sigmoidf_(g1[j]) * acc[ai][bj][m][1][j]; }
                    bf16_t* op = O + r * ldc + col0 + bj * HALF;
                    if (ACCUM) { const u32x4 ow = *(const u32x4*)op;
                        v0 = v0 + (f32x4){bf_lo(ow.x), bf_hi(ow.x), bf_lo(ow.y), bf_hi(ow.y)}; v1 = v1 + (f32x4){bf_lo(ow.z), bf_hi(ow.z), bf_lo(ow.w), bf_hi(ow.w)}; }
                    *(u32x4*)op = pack8(v0, v1); } }
    }
};
struct EpiZt {
    static constexpr bool PERM = true, IDEMPOTENT = false; static constexpr int REPX = REP_F1;
    bf16_t* Z;
    __device__ __forceinline__ void operator()(const f32x4 (&acc)[2][2][4][2], const Unit& u, int wr, int wc, int fr, int fq) const {
        const int a0 = wc * 32 + 8 * fq;
#pragma unroll
        for (int ai = 0; ai < 2; ++ai)
#pragma unroll
            for (int m = 0; m < 4; ++m) { const int mi = wr * 64 + m * 16 + fr;
#pragma unroll
                for (int bj = 0; bj < 2; ++bj) { const int b = 2 * u.pn + bj;
                    *(u32x4*)(Z + ((size_t)((u.pm * 128 + mi) * 128 + b)) * 256 + ai * 128 + a0) = pack8(acc[ai][bj][m][0], acc[ai][bj][m][1]); } }
    }
};
struct EpiYt {
    static constexpr bool PERM = true, IDEMPOTENT = true; static constexpr int REPX = 1;
    bf16_t* Y; const float* tw;
    __device__ __forceinline__ void operator()(const f32x4 (&acc)[2][2][4][2], const Unit& u, int wr, int wc, int fr, int fq) const {
        const int b0 = wc * 32 + 8 * fq;
#pragma unroll
        for (int m = 0; m < 4; ++m) { const int c = wr * 64 + m * 16 + fr;
            f32x4 t[4];
#pragma unroll
            for (int q = 0; q < 4; ++q) t[q] = *(const f32x4*)(tw + ((size_t)c * 128 + b0) * 2 + 4 * q);
#pragma unroll
            for (int bj = 0; bj < 2; ++bj) { const int gm = 2 * u.pn + bj;
                f32x4 re[2], im[2];
#pragma unroll
                for (int n = 0; n < 2; ++n)
#pragma unroll
                    for (int j = 0; j < 4; ++j) { const int e = 4 * n + j; const float tc = t[e >> 1][(e & 1) * 2], ts = t[e >> 1][(e & 1) * 2 + 1];
                        const float xr = acc[0][bj][m][n][j], xi = acc[1][bj][m][n][j];
                        re[n][j] = xr * tc - xi * ts; im[n][j] = xr * ts + xi * tc; }
                bf16_t* p = Y + ((size_t)(c * 1024 + gm) * 2) * 128 + b0;
                *(u32x4*)p = pack8(re[0], re[1]); *(u32x4*)(p + 128) = pack8(im[0], im[1]); } }
    }
};
struct EpiXf {
    static constexpr bool PERM = true, IDEMPOTENT = true; static constexpr int REPX = 1;
    bf16_t* X; int ldx;
    __device__ __forceinline__ void operator()(const f32x4 (&acc)[2][2][4][2], const Unit& u, int wr, int wc, int fr, int fq) const {
        const int c = u.pn >> 2, gm0 = (u.pn & 3) * 256 + wc * 32 + 8 * fq;
#pragma unroll
        for (int m = 0; m < 4; ++m) { const int d = wr * 64 + m * 16 + fr;
#pragma unroll
            for (int bj = 0; bj < 2; ++bj) *(u32x4*)(X + (size_t)(c + 128 * d) * ldx + gm0 + bj * HALF) = pack8(acc[0][bj][m][0], acc[0][bj][m][1]); }
    }
};

typedef long l2_t __attribute__((ext_vector_type(2)));
template <class C, class Epi, class Sched, bool ALIGN_EPI = false, bool SP2 = false, bool F8 = false>
__device__ __forceinline__ void gemm_phase(PG8_LAS unsigned char* lds, const Gemm g, const Sched& S, const Epi& E) {
    const int tid = threadIdx.x, wid = __builtin_amdgcn_readfirstlane(tid >> 6), lane = tid & 63, wr = wid >> 2, wc = wid & 3, fr = lane & 15, fq = lane >> 4;
    constexpr int K = C::K, nt = K / BK;
    unsigned voffA[2], voffB[2];
#pragma unroll
    for (int i = 0; i < 2; ++i) { int R, Cc; stage_rc(tid * 16 + i * 8192, R, Cc); const int Rb = Epi::PERM ? ((R & ~31) + perm32(R & 31)) : R;
        voffA[i] = (unsigned)R * C::rowA + (unsigned)Cc * 2u; voffB[i] = (unsigned)Rb * C::rowB + (unsigned)Cc * 2u; }
    const size_t kstep = (size_t)(BK * 2);
    constexpr size_t hstepA = C::hstepA, hstepB = C::hstepB;
    const unsigned ldsw = (unsigned)wid * 1024u;
    const int aoff = lds_byte(wr * 64 + fr, fq * 8), boff = lds_byte(wc * 32 + fr, fq * 8);
#define PG8_SA(b, h) (((b) * 2 + (h)) * HTB)
#define PG8_SB(b, h) ((4 + (b) * 2 + (h)) * HTB)
#define PG8_STAGE(bufoff, gbase, voff) do { _Pragma("unroll") for (int _i = 0; _i < 2; ++_i) \
        __builtin_amdgcn_global_load_lds((const unsigned*)((const char*)(gbase) + (voff)[_i]), (PG8_LAS unsigned*)(lds + (bufoff) + ldsw + _i * 8192), 16, 0, 0); } while (0)
#define PG8_LDA(dst, b, h) do { _Pragma("unroll") for (int m = 0; m < 4; ++m) _Pragma("unroll") for (int k = 0; k < 2; ++k) dst[m][k] = *(const PG8_LAS bf16x8*)(lds + PG8_SA(b, h) + aoff + m * 2048 + k * 1024); } while (0)
#define PG8_LDB(dst, b, h) do { _Pragma("unroll") for (int n = 0; n < 2; ++n) _Pragma("unroll") for (int k = 0; k < 2; ++k) dst[n][k] = *(const PG8_LAS bf16x8*)(lds + PG8_SB(b, h) + boff + n * 2048 + k * 1024); } while (0)
#define PG8_MMA(ai, bj, At, Bt) do { __builtin_amdgcn_s_setprio(1); _Pragma("unroll") for (int m = 0; m < 4; ++m) _Pragma("unroll") for (int n = 0; n < 2; ++n) _Pragma("unroll") for (int k = 0; k < 2; ++k) { \
        if constexpr (F8) { const l2_t b_ = __builtin_bit_cast(l2_t, Bt[n][k]), a_ = __builtin_bit_cast(l2_t, At[m][k]); \
            acc[ai][bj][m][n] = __builtin_amdgcn_mfma_f32_16x16x32_fp8_fp8(b_[0], a_[0], acc[ai][bj][m][n], 0, 0, 0); \
            acc[ai][bj][m][n] = __builtin_amdgcn_mfma_f32_16x16x32_fp8_fp8(b_[1], a_[1], acc[ai][bj][m][n], 0, 0, 0); } \
        else acc[ai][bj][m][n] = __builtin_amdgcn_mfma_f32_16x16x32_bf16(Bt[n][k], At[m][k], acc[ai][bj][m][n], 0, 0, 0); } \
        __builtin_amdgcn_s_setprio(0); } while (0)
#define PG8_WAIT_V(n) asm volatile("s_waitcnt vmcnt(" #n ")" ::: "memory")
#define PG8_WAIT_L(n) asm volatile("s_waitcnt lgkmcnt(" #n ")" ::: "memory")
#define PG8_BAR __builtin_amdgcn_s_barrier()
#define PG8_SCHED __builtin_amdgcn_sched_barrier(0)
#define PG8_TA(u) (g.A + (size_t)(u).pm * C::pmA + (size_t)(u).pn * C::pnA)
#define PG8_TB(u) (g.B + (size_t)(u).pm * C::pmB + (size_t)(u).pn * C::pnB)
    Unit cur, nxt; int ui = 0;
    if (!S.next(0, cur)) return;
    f32x4 acc[2][2][4][2];
#pragma unroll
    for (int a = 0; a < 2; ++a)
#pragma unroll
        for (int b = 0; b < 2; ++b)
#pragma unroll
            for (int m = 0; m < 4; ++m)
#pragma unroll
                for (int n = 0; n < 2; ++n) acc[a][b][m][n] = (f32x4){0.f, 0.f, 0.f, 0.f};
    bf16x8 At[4][2], B0[2][2], B1[2][2];
    const char* cA = PG8_TA(cur); const char* cB = PG8_TB(cur);
    if constexpr (SP2) {
        PG8_STAGE(PG8_SB(0, 0), cB, voffB); PG8_STAGE(PG8_SB(0, 1), cB + hstepB, voffB); PG8_STAGE(PG8_SA(0, 0), cA, voffA); PG8_STAGE(PG8_SA(0, 1), cA + hstepA, voffA);
        if (wr == 1) PG8_BAR;
        PG8_WAIT_V(2); PG8_BAR;
        PG8_STAGE(PG8_SB(1, 0), cB + kstep, voffB); PG8_STAGE(PG8_SA(1, 0), cA + kstep, voffA); PG8_STAGE(PG8_SB(1, 1), cB + hstepB + kstep, voffB);
        PG8_WAIT_V(6); PG8_BAR;
    } else {
        PG8_STAGE(PG8_SB(0, 0), cB, voffB); PG8_STAGE(PG8_SA(0, 0), cA, voffA); PG8_STAGE(PG8_SB(0, 1), cB + hstepB, voffB); PG8_STAGE(PG8_SA(0, 1), cA + hstepA, voffA);
        if (wr == 1) PG8_BAR;
        PG8_WAIT_V(4); PG8_BAR;
        PG8_STAGE(PG8_SB(1, 0), cB + kstep, voffB); PG8_STAGE(PG8_SA(1, 0), cA + kstep, voffA); PG8_STAGE(PG8_SB(1, 1), cB + hstepB + kstep, voffB);
        PG8_WAIT_V(6); PG8_BAR;
    }
    for (;;) {
        const bool has_next = S.next(ui + 1, nxt);
        const char* nA = has_next ? PG8_TA(nxt) : cA; const char* nB = has_next ? PG8_TB(nxt) : cB;
#pragma nounroll
        for (int t = 0; t < nt; t += 2) {
            const bool last = (t == nt - 2);
            const char* a1 = cA + (size_t)(t + 1) * kstep;
            const char* a2 = last ? nA : cA + (size_t)(t + 2) * kstep; const char* b2 = last ? nB : cB + (size_t)(t + 2) * kstep;
            const char* a3 = a2 + kstep; const char* b3 = b2 + kstep;
            if constexpr (SP2) {
            PG8_LDB(B0, 0, 0); PG8_LDB(B1, 0, 1); PG8_SCHED; PG8_LDA(At, 0, 0); PG8_STAGE(PG8_SA(1, 1), a1 + hstepA, voffA);
            PG8_WAIT_V(8); PG8_WAIT_L(0); PG8_BAR; PG8_MMA(0, 0, At, B0); PG8_MMA(0, 1, At, B1); PG8_BAR; PG8_SCHED;
            PG8_LDA(At, 0, 1); PG8_STAGE(PG8_SB(0, 0), b2, voffB); PG8_STAGE(PG8_SB(0, 1), b2 + hstepB, voffB); PG8_STAGE(PG8_SA(0, 0), a2, voffA);
            PG8_WAIT_V(8); PG8_WAIT_L(0); PG8_BAR; PG8_MMA(1, 0, At, B0); PG8_MMA(1, 1, At, B1); PG8_BAR; PG8_SCHED;
            PG8_LDB(B0, 1, 0); PG8_LDB(B1, 1, 1); PG8_SCHED; PG8_LDA(At, 1, 0); PG8_STAGE(PG8_SA(0, 1), a2 + hstepA, voffA);
            PG8_WAIT_V(8); PG8_WAIT_L(0); PG8_BAR; PG8_MMA(0, 0, At, B0); PG8_MMA(0, 1, At, B1); PG8_BAR; PG8_SCHED;
            PG8_LDA(At, 1, 1); PG8_STAGE(PG8_SB(1, 0), b3, voffB); PG8_STAGE(PG8_SB(1, 1), b3 + hstepB, voffB); PG8_STAGE(PG8_SA(1, 0), a3, voffA);
            PG8_WAIT_V(8); PG8_WAIT_L(0); PG8_BAR; PG8_MMA(1, 0, At, B0); PG8_MMA(1, 1, At, B1); PG8_BAR; PG8_SCHED;
            } else {
            PG8_LDB(B0, 0, 0); PG8_SCHED; PG8_LDA(At, 0, 0); PG8_STAGE(PG8_SA(1, 1), a1 + hstepA, voffA);
            PG8_WAIT_L(8); PG8_BAR; PG8_WAIT_L(0); PG8_MMA(0, 0, At, B0); PG8_BAR; PG8_SCHED;
            PG8_LDB(B1, 0, 1); PG8_STAGE(PG8_SB(0, 0), b2, voffB);
            PG8_BAR; PG8_WAIT_L(0); PG8_MMA(0, 1, At, B1); PG8_BAR;
            PG8_LDA(At, 0, 1); PG8_STAGE(PG8_SA(0, 0), a2, voffA);
            PG8_BAR; PG8_WAIT_L(0); PG8_MMA(1, 0, At, B0); PG8_BAR; PG8_SCHED;
            PG8_STAGE(PG8_SB(0, 1), b2 + hstepB, voffB);
            PG8_WAIT_V(6); PG8_BAR; PG8_MMA(1, 1, At, B1); PG8_BAR;
            PG8_LDB(B0, 1, 0); PG8_SCHED; PG8_LDA(At, 1, 0); PG8_STAGE(PG8_SA(0, 1), a2 + hstepA, voffA);
            PG8_WAIT_L(8); PG8_BAR; PG8_WAIT_L(0); PG8_MMA(0, 0, At, B0); PG8_BAR; PG8_SCHED;
            PG8_LDB(B1, 1, 1); PG8_STAGE(PG8_SB(1, 0), b3, voffB);
            PG8_BAR; PG8_WAIT_L(0); PG8_MMA(0, 1, At, B1); PG8_BAR;
            PG8_LDA(At, 1, 1); PG8_STAGE(PG8_SA(1, 0), a3, voffA);
            PG8_BAR; PG8_WAIT_L(0); PG8_MMA(1, 0, At, B0); PG8_BAR; PG8_SCHED;
            PG8_STAGE(PG8_SB(1, 1), b3 + hstepB, voffB);
            PG8_WAIT_V(6); PG8_BAR; PG8_MMA(1, 1, At, B1); PG8_BAR;
            }
        }
        if constexpr (ALIGN_EPI) { if (wr == 0) PG8_BAR; }
        E(acc, cur, wr, wc, fr, fq);
        if (!has_next) break;
#pragma unroll
        for (int a = 0; a < 2; ++a)
#pragma unroll
            for (int b = 0; b < 2; ++b)
#pragma unroll
                for (int m = 0; m < 4; ++m)
#pragma unroll
                    for (int n = 0; n < 2; ++n) acc[a][b][m][n] = (f32x4){0.f, 0.f, 0.f, 0.f};
        cur = nxt; cA = nA; cB = nB; ++ui;
        if constexpr (ALIGN_EPI) { if (wr == 1) PG8_BAR; }
    }
    PG8_WAIT_V(0);
    if constexpr (!ALIGN_EPI) { if (wr == 0) PG8_BAR; }
    PG8_BAR;
#undef PG8_SA
#undef PG8_SB
#undef PG8_STAGE
#undef PG8_LDA
#undef PG8_LDB
#undef PG8_MMA
#undef PG8_WAIT_V
#undef PG8_WAIT_L
#undef PG8_BAR
#undef PG8_SCHED
#undef PG8_TA
#undef PG8_TB
}
}

namespace att {
using bf16 = __hip_bfloat16;
constexpr int   D = 128, NW = 8, QBLK = 32, KVBLK = 64;
constexpr float SCALE = 0.088388347648318440f;
constexpr float THR = 8.f;
constexpr int LDQ = 8192, LDK = 8192, LDO = 2048;
constexpr size_t SHM_V = KVBLK * D * 2, SHM_K = KVBLK * D * 2, SHM_ATTN = 2 * SHM_V + 2 * SHM_K + NW * 64 * 4;
using bf16x8 = __attribute__((ext_vector_type(8))) short;
using s16x4  = __attribute__((ext_vector_type(4))) short;
using f32x16 = __attribute__((ext_vector_type(16))) float;
using u32x4  = __attribute__((ext_vector_type(4))) unsigned;
#define KSWZ(row, colB) ((row) * 256 + ((colB) ^ (((row) & 7) << 4)))
#define SBAR() __builtin_amdgcn_sched_barrier(0)
__device__ __forceinline__ int crow(int r, int hi) { return (r & 3) + 8 * (r >> 2) + 4 * hi; }
__device__ __forceinline__ unsigned cvtpk(float lo, float hi) { unsigned r; asm volatile("v_cvt_pk_bf16_f32 %0, %1, %2" : "=v"(r) : "v"(lo), "v"(hi)); return r; }
__device__ __forceinline__ bf16x8 ld8(const bf16* p) { return *reinterpret_cast<const bf16x8*>(p); }

__device__ __forceinline__ void partialSM(f32x16& p0, f32x16& p1, float& m_reg, float& mn, float& alpha) {
  constexpr float C = SCALE * 1.4426950408889634f;
  float pmax = p0[0]; for (int r = 1; r < 16; ++r) pmax = fmaxf(pmax, p0[r]); for (int r = 0; r < 16; ++r) pmax = fmaxf(pmax, p1[r]);
  { auto rr = __builtin_amdgcn_permlane32_swap(__float_as_uint(pmax), __float_as_uint(pmax), false, false);
    pmax = fmaxf(__uint_as_float(rr[0]), __uint_as_float(rr[1])); }
  if (__builtin_expect(__all(pmax - m_reg <= THR / SCALE), 1)) { mn = m_reg; alpha = 1.f; }
  else { mn = fmaxf(m_reg, pmax); alpha = __builtin_amdgcn_exp2f((m_reg - mn) * C); m_reg = mn; }
  float mnC = -mn * C;
  for (int r = 0; r < 16; ++r) p0[r] = fmaf(p0[r], C, mnC); for (int r = 0; r < 16; ++r) p1[r] = fmaf(p1[r], C, mnC);
  for (int r = 0; r < 16; ++r) p0[r] = __builtin_amdgcn_exp2f(p0[r]);
}
__device__ __forceinline__ void finishSM(f32x16& p0, f32x16& p1, float alpha, float& l_reg, bf16x8& pa0, bf16x8& pa1, bf16x8& pa2, bf16x8& pa3) {
  for (int r = 0; r < 16; ++r) p1[r] = __builtin_amdgcn_exp2f(p1[r]);
  float ps = 0; for (int r = 0; r < 16; ++r) ps += p0[r]; for (int r = 0; r < 16; ++r) ps += p1[r];
  { auto rr = __builtin_amdgcn_permlane32_swap(__float_as_uint(ps), __float_as_uint(ps), false, false);
    ps = __uint_as_float(rr[0]) + __uint_as_float(rr[1]); }
  l_reg = l_reg * alpha + ps;
#define PK4(P, BASE, OUT) do { unsigned a0 = cvtpk(P[BASE + 0], P[BASE + 1]), a1 = cvtpk(P[BASE + 2], P[BASE + 3]);   \
    unsigned b0 = cvtpk(P[BASE + 4], P[BASE + 5]), b1 = cvtpk(P[BASE + 6], P[BASE + 7]);                              \
    auto r0 = __builtin_amdgcn_permlane32_swap(a0, b0, false, false); auto r1 = __builtin_amdgcn_permlane32_swap(a1, b1, false, false); \
    u32x4 w = {r0[0], r1[0], r0[1], r1[1]}; OUT = *reinterpret_cast<bf16x8*>(&w); } while (0)
  PK4(p0, 0, pa0); PK4(p0, 8, pa1); PK4(p1, 0, pa2); PK4(p1, 8, pa3);
#undef PK4
}
__device__ __forceinline__ void qkt(f32x16& p0, f32x16& p1, const bf16* Ks, const bf16x8* qr, int r32, int hi) {
  p0 = f32x16{}; p1 = f32x16{};
  for (int d0 = 0; d0 < 8; ++d0) { int cb = (d0 * 16 + hi * 8) * 2;
    bf16x8 b0 = *reinterpret_cast<const bf16x8*>((const char*)Ks + KSWZ(r32, cb));
    bf16x8 b1 = *reinterpret_cast<const bf16x8*>((const char*)Ks + KSWZ(32 + r32, cb));
    p0 = __builtin_amdgcn_mfma_f32_32x32x16_bf16(b0, qr[d0], p0, 0, 0, 0);
    p1 = __builtin_amdgcn_mfma_f32_32x32x16_bf16(b1, qr[d0], p1, 0, 0, 0); }
}
__device__ __forceinline__ int v_st(int k, int c) { const int kk = (k & ~0xC) | ((k & 4) << 1) | ((k & 8) >> 1); return ((kk >> 3) * 4 + (c >> 5)) * 512 + ((kk & 7) * 32 + (c & 31)) * 2; }
__device__ __forceinline__ int v_rd_base(int lane) { return ((lane & 3) << 3) | (((lane >> 2) & 3) << 6) | (((lane >> 4) & 1) << 5) | (((lane >> 5) & 1) << 8); }
constexpr int v_rd_off(int d0, int ks, int half) { return d0 * 512 + ks * 4096 + half * 2048; }
template <int OFF> __device__ __forceinline__ s16x4 tr_read(int vb) {
  s16x4 r; asm volatile("ds_read_b64_tr_b16 %0, %1 offset:%2" : "=&v"(r) : "v"(vb), "i"(OFF) : "memory"); return r;
}
template <int D0> __device__ __forceinline__ void pv_one(f32x16& od, int vb, bf16x8 pa0, bf16x8 pa1, bf16x8 pa2, bf16x8 pa3) {
  const s16x4 l0 = tr_read<v_rd_off(D0, 0, 0)>(vb), h0 = tr_read<v_rd_off(D0, 0, 1)>(vb), l1 = tr_read<v_rd_off(D0, 1, 0)>(vb), h1 = tr_read<v_rd_off(D0, 1, 1)>(vb);
  const s16x4 l2 = tr_read<v_rd_off(D0, 2, 0)>(vb), h2 = tr_read<v_rd_off(D0, 2, 1)>(vb), l3 = tr_read<v_rd_off(D0, 3, 0)>(vb), h3 = tr_read<v_rd_off(D0, 3, 1)>(vb);
  asm volatile("s_waitcnt lgkmcnt(0)" ::: "memory"); SBAR();
#define PK(L, H) (bf16x8){L[0], L[1], L[2], L[3], H[0], H[1], H[2], H[3]}
  od = __builtin_amdgcn_mfma_f32_32x32x16_bf16(pa0, PK(l0, h0), od, 0, 0, 0);
  od = __builtin_amdgcn_mfma_f32_32x32x16_bf16(pa1, PK(l1, h1), od, 0, 0, 0);
  od = __builtin_amdgcn_mfma_f32_32x32x16_bf16(pa2, PK(l2, h2), od, 0, 0, 0);
  od = __builtin_amdgcn_mfma_f32_32x32x16_bf16(pa3, PK(l3, h3), od, 0, 0, 0);
#undef PK
}
__device__ __forceinline__ void pv_d0(f32x16* o, int vb, bf16x8 pa0, bf16x8 pa1, bf16x8 pa2, bf16x8 pa3) {
  pv_one<0>(o[0], vb, pa0, pa1, pa2, pa3); pv_one<1>(o[1], vb, pa0, pa1, pa2, pa3); pv_one<2>(o[2], vb, pa0, pa1, pa2, pa3); pv_one<3>(o[3], vb, pa0, pa1, pa2, pa3);
}

__device__ __forceinline__ void attn_dense_body(const bf16* Qb, const bf16* __restrict__ Kh, const bf16* __restrict__ Vh,
                                                bf16* Ob, int seq, char* lds) {
  constexpr int SDEPTH = 2;
  const int tid = threadIdx.x, wid = tid >> 6, lane = tid & 63, r32 = lane & 31, hi = lane >> 5;
  bf16* V_lds = (bf16*)lds; bf16* K_lds = (bf16*)(lds + 2 * SHM_V);
  float* ws = (float*)(lds + 2 * SHM_V + 2 * SHM_K) + wid * 64; float* li_l = ws; float* al_l = ws + 32;
  float m_reg = -1e30f, l_reg = 0; f32x16 o[4] = {}; bf16x8 qr[8];
  const bf16* Qw = Qb + (long)(wid * QBLK + r32) * LDQ + hi * 8;
#pragma unroll
  for (int d0 = 0; d0 < 8; ++d0) qr[d0] = ld8(Qw + d0 * 16);
  const int sr = tid >> 4, sc = (tid & 15) * 8, vst0 = v_st(sr, sc), vst1 = v_st(32 + sr, sc);
  const int vb0 = (int)(uintptr_t)V_lds + v_rd_base(lane);
  struct { bf16x8 vs0, vs1, ks0, ks1; } sr_[SDEPTH];
#define SLOAD(i, k0) do { sr_[i].vs0 = ld8(&Vh[(long)((k0) + sr) * LDK + sc]); sr_[i].vs1 = ld8(&Vh[(long)((k0) + 32 + sr) * LDK + sc]); \
    sr_[i].ks0 = ld8(&Kh[(long)((k0) + sr) * LDK + sc]); sr_[i].ks1 = ld8(&Kh[(long)((k0) + 32 + sr) * LDK + sc]); } while (0)
#define SWRITE(b, i) do { *(bf16x8*)((char*)V_lds + (b) * SHM_V + vst0) = sr_[i].vs0;          \
    *(bf16x8*)((char*)V_lds + (b) * SHM_V + vst1) = sr_[i].vs1; int kc = sc * 2;               \
    *(bf16x8*)((char*)K_lds + (b) * SHM_K + KSWZ(sr, kc)) = sr_[i].ks0;                       \
    *(bf16x8*)((char*)K_lds + (b) * SHM_K + KSWZ(32 + sr, kc)) = sr_[i].ks1; } while (0)
#define SWAIT() do { asm volatile("s_waitcnt vmcnt(4)" ::: "memory"); } while (0)
#define RESC(a) do { if (__any((a) < 1.f)) { if (hi == 0) al_l[r32] = (a); asm volatile("s_waitcnt lgkmcnt(0)" ::: "memory"); \
    for (int d = 0; d < 4; ++d) for (int r = 0; r < 16; ++r) o[d][r] *= al_l[crow(r, hi)]; } } while (0)
  f32x16 pA0, pA1, pB0, pB1; float mnA, mnB, alA, alB; bf16x8 pa0, pa1, pa2, pa3; const int NT = seq / KVBLK;
  constexpr int SE = 0, SO = SDEPTH - 1;
  SLOAD(SE, 0); asm volatile("s_waitcnt vmcnt(0)" ::: "memory"); SWRITE(0, SE); __syncthreads();
  qkt(pA0, pA1, K_lds, qr, r32, hi); partialSM(pA0, pA1, m_reg, mnA, alA);
  SLOAD(SO, KVBLK); if (2 < NT) SLOAD(SE, 2 * KVBLK);
  SWAIT(); SWRITE(1, SO); __syncthreads();
  for (int j = 1; j + 1 < NT; j += 2) {
    SBAR(); qkt(pB0, pB1, (bf16*)((char*)K_lds + SHM_K), qr, r32, hi);
    finishSM(pA0, pA1, alA, l_reg, pa0, pa1, pa2, pa3); SBAR();
    SLOAD(SO, (j + SDEPTH) * KVBLK); SBAR();
    pv_d0(o, vb0, pa0, pa1, pa2, pa3); partialSM(pB0, pB1, m_reg, mnB, alB);
    __syncthreads(); SWAIT(); SWRITE(0, SE);
    RESC(alB); __syncthreads();
    SBAR(); qkt(pA0, pA1, K_lds, qr, r32, hi);
    finishSM(pB0, pB1, alB, l_reg, pa0, pa1, pa2, pa3); SBAR();
    if (j + 3 < NT) SLOAD(SE, (j + 1 + SDEPTH) * KVBLK); SBAR();
    pv_d0(o, vb0 + (int)SHM_V, pa0, pa1, pa2, pa3); partialSM(pA0, pA1, m_reg, mnA, alA);
    __syncthreads(); SWAIT(); SWRITE(1, SO);
    RESC(alA); __syncthreads();
  }
  SBAR(); qkt(pB0, pB1, (bf16*)((char*)K_lds + SHM_K), qr, r32, hi);
  finishSM(pA0, pA1, alA, l_reg, pa0, pa1, pa2, pa3); SBAR();
  pv_d0(o, vb0, pa0, pa1, pa2, pa3); partialSM(pB0, pB1, m_reg, mnB, alB);
  __syncthreads(); RESC(alB);
  finishSM(pB0, pB1, alB, l_reg, pa0, pa1, pa2, pa3); SBAR();
  pv_d0(o, vb0 + (int)SHM_V, pa0, pa1, pa2, pa3);
  if (hi == 0) li_l[r32] = l_reg; asm volatile("s_waitcnt lgkmcnt(0)" ::: "memory");
  float rli[16];
#pragma unroll
  for (int r = 0; r < 16; ++r) rli[r] = __builtin_amdgcn_rcpf(li_l[crow(r, hi)]);
  unsigned short* Ow = (unsigned short*)Ob + (long)(wid * QBLK) * LDO;
#pragma unroll
  for (int r = 0; r < 16; ++r) { int orow = crow(r, hi);
#pragma unroll
    for (int d0 = 0; d0 < 4; ++d0) Ow[(long)orow * LDO + d0 * 32 + r32] = (unsigned short)(cvtpk(o[d0][r] * rli[r], 0.f) & 0xffffu); }
#undef SLOAD
#undef SWRITE
#undef SWAIT
#undef RESC
}
}


namespace att8 {
using bf16 = __hip_bfloat16;
typedef int v8i __attribute__((ext_vector_type(8)));
typedef int v4i __attribute__((ext_vector_type(4)));
using f32x16 = __attribute__((ext_vector_type(16))) float;
typedef float f2 __attribute__((ext_vector_type(2)));
constexpr int D = 128, NW = 8, QBLK = 32, KVBLK = 64;
constexpr float SCALE = 0.088388347648318440f;
constexpr float THR = 8.f;
constexpr int LDQ8 = 2048, LDK8 = 128, LDO = 2048;
constexpr int SHM_K8 = 8192, SHM_V8 = 8192;
#define SB8() __builtin_amdgcn_sched_barrier(0)
constexpr int SCL = 0x7f7f7f7f;
__device__ __forceinline__ int crow(int r, int hi) { return (r & 3) + 8 * (r >> 2) + 4 * hi; }
__host__ __device__ __forceinline__ int vpos(int key) { return 32 * ((key >> 2) & 1) + 16 * (key >> 5) + (key & 3) + 4 * ((key >> 3) & 3); }
__host__ __device__ __forceinline__ int vkey(int pos) { const int hi = pos >> 5, e = pos & 31, p = e >> 4, r = e & 15; return 32 * p + (r & 3) + 8 * (r >> 2) + 4 * hi; }

__device__ __forceinline__ void partialSM(f32x16& p0, f32x16& p1, float& m_reg, float& mn, float& alpha) {
  constexpr float C = SCALE * 1.4426950408889634f;
  float pmax = p0[0]; for (int r = 1; r < 16; ++r) pmax = fmaxf(pmax, p0[r]); for (int r = 0; r < 16; ++r) pmax = fmaxf(pmax, p1[r]);
  { auto rr = __builtin_amdgcn_permlane32_swap(__float_as_uint(pmax), __float_as_uint(pmax), false, false);
    pmax = fmaxf(__uint_as_float(rr[0]), __uint_as_float(rr[1])); }
  if (__builtin_expect(__all(pmax - m_reg <= THR / SCALE), 1)) { mn = m_reg; alpha = 1.f; }
  else { mn = fmaxf(m_reg, pmax); alpha = __builtin_amdgcn_exp2f((m_reg - mn) * C); m_reg = mn; }
  const float mnC = -mn * C; const f2 c2 = {C, C}, m2 = {mnC, mnC};
#pragma unroll
  for (int r = 0; r < 8; ++r) { f2 v = {p0[2 * r], p0[2 * r + 1]}; v = v * c2 + m2; p0[2 * r] = v.x; p0[2 * r + 1] = v.y;
                                f2 w = {p1[2 * r], p1[2 * r + 1]}; w = w * c2 + m2; p1[2 * r] = w.x; p1[2 * r + 1] = w.y; }
#pragma unroll
  for (int r = 0; r < 16; ++r) p0[r] = __builtin_amdgcn_exp2f(p0[r]);
}
__device__ __forceinline__ void finishSM(f32x16& p0, f32x16& p1, float alpha, float& l_reg, v8i& pa) {
  for (int r = 0; r < 16; ++r) p1[r] = __builtin_amdgcn_exp2f(p1[r]);
  f2 s2 = {p0[0], p0[1]};
#pragma unroll
  for (int r = 1; r < 8; ++r) s2 += (f2){p0[2 * r], p0[2 * r + 1]};
#pragma unroll
  for (int r = 0; r < 8; ++r) s2 += (f2){p1[2 * r], p1[2 * r + 1]};
  float ps = s2.x + s2.y;
  { auto rr = __builtin_amdgcn_permlane32_swap(__float_as_uint(ps), __float_as_uint(ps), false, false);
    ps = __uint_as_float(rr[0]) + __uint_as_float(rr[1]); }
  l_reg = l_reg * alpha + ps;
#pragma unroll
  for (int i = 0; i < 4; ++i) { int w = __builtin_amdgcn_cvt_pk_bf8_f32(p0[4 * i], p0[4 * i + 1], 0, false); w = __builtin_amdgcn_cvt_pk_bf8_f32(p0[4 * i + 2], p0[4 * i + 3], w, true); pa[i] = w; }
#pragma unroll
  for (int i = 0; i < 4; ++i) { int w = __builtin_amdgcn_cvt_pk_bf8_f32(p1[4 * i], p1[4 * i + 1], 0, false); w = __builtin_amdgcn_cvt_pk_bf8_f32(p1[4 * i + 2], p1[4 * i + 3], w, true); pa[4 + i] = w; }
}
__device__ __forceinline__ v8i ld32(const char* a, const char* b) { const v4i x = *(const v4i*)a, y = *(const v4i*)b; return (v8i){x[0], x[1], x[2], x[3], y[0], y[1], y[2], y[3]}; }
__device__ __forceinline__ void qkt(f32x16& p0, f32x16& p1, const char* Ks, const v8i* qr, int kro, const int (&kx)[2][2]) {
  p0 = f32x16{}; p1 = f32x16{};
#pragma unroll
  for (int db = 0; db < 2; ++db) {
    const v8i k0 = ld32(Ks + kro + kx[db][0], Ks + kro + kx[db][1]);
    const v8i k1 = ld32(Ks + 4096 + kro + kx[db][0], Ks + 4096 + kro + kx[db][1]);
    p0 = __builtin_amdgcn_mfma_scale_f32_32x32x64_f8f6f4(k0, qr[db], p0, 0, 0, 0, SCL, 0, SCL);
    p1 = __builtin_amdgcn_mfma_scale_f32_32x32x64_f8f6f4(k1, qr[db], p1, 0, 0, 0, SCL, 0, SCL); }
}
__device__ __forceinline__ void pv(f32x16* o, const char* Vs, const v8i pa, int vro, const int (&vx)[2]) {
#pragma unroll
  for (int d0 = 0; d0 < 4; ++d0) { const v8i vf = ld32(Vs + d0 * 2048 + vro + vx[0], Vs + d0 * 2048 + vro + vx[1]);
    o[d0] = __builtin_amdgcn_mfma_scale_f32_32x32x64_f8f6f4(pa, vf, o[d0], 1, 0, 0, SCL, 0, SCL); }
}
__device__ __forceinline__ void attn_body(const unsigned char* Qb, const unsigned char* __restrict__ Kh, const unsigned char* __restrict__ Vh, unsigned char* Ob, int seq, char* lds) {
  const int tid = threadIdx.x, wid = tid >> 6, lane = tid & 63, r32 = lane & 31, hi = lane >> 5;
  char* V_lds = lds; char* K_lds = lds + 3 * SHM_V8;
  float* ws = (float*)(lds + 3 * SHM_V8 + 3 * SHM_K8) + wid * 64; float* li_l = ws; float* al_l = ws + 32;
  float m_reg = -1e30f, l_reg = 0; f32x16 o[4] = {}; v8i qr[2];
  const unsigned char* Qw = Qb + (long)(wid * QBLK + r32) * LDQ8 + hi * 32;
#pragma unroll
  for (int db = 0; db < 2; ++db) qr[db] = ld32((const char*)Qw + db * 64, (const char*)Qw + db * 64 + 16);
  const int skey = tid >> 3, skc = tid & 7, kst = skey * 128 + ((skc ^ ((skey >> 1) & 7)) << 4);
  const int sd = tid >> 2, svc = tid & 3, vst = sd * 64 + ((svc ^ ((sd >> 2) & 3)) << 4);
  const unsigned char* kg = Kh + skey * 128 + skc * 16;
  const unsigned char* vg = Vh + sd * 64 + svc * 16;
  const int kro = r32 * 128, ksw = (r32 >> 1) & 7, vro = r32 * 64, vsw = (r32 >> 2) & 3;
  int kx[2][2], vx[2];
#pragma unroll
  for (int db = 0; db < 2; ++db)
#pragma unroll
    for (int j = 0; j < 2; ++j) kx[db][j] = ((4 * db + 2 * hi + j) ^ ksw) << 4;
#pragma unroll
  for (int j = 0; j < 2; ++j) vx[j] = ((2 * hi + j) ^ vsw) << 4;
  struct { v4i ks, vs; } sr_[2];
#define SLOAD(i, k0) do { sr_[i].ks = *(const v4i*)(kg + (long)(k0) * 128); sr_[i].vs = *(const v4i*)(vg + (long)(k0) * 128); } while (0)
#define SWRITE(b, i) do { *(v4i*)(K_lds + (b) * SHM_K8 + kst) = sr_[i].ks; *(v4i*)(V_lds + (b) * SHM_V8 + vst) = sr_[i].vs; } while (0)
#define SWAIT() do { asm volatile("s_waitcnt vmcnt(2)" ::: "memory"); } while (0)
#define RESC(a) do { if (__any((a) < 1.f)) { if (hi == 0) al_l[r32] = (a); asm volatile("s_waitcnt lgkmcnt(0)" ::: "memory"); \
    for (int d = 0; d < 4; ++d) for (int r = 0; r < 16; ++r) o[d][r] *= al_l[crow(r, hi)]; } } while (0)
  f32x16 pA0, pA1, pB0, pB1; float mnA, mnB, alA, alB; v8i pa; const int NT = seq / KVBLK;
  int b_prev = 0, b_cur = 0, b_next = 1;
#define ROT3() do { b_prev = b_cur; b_cur = b_next; b_next = (b_next == 2) ? 0 : b_next + 1; } while (0)
  SLOAD(0, 0); asm volatile("s_waitcnt vmcnt(0)" ::: "memory"); SWRITE(0, 0); SLOAD(1, KVBLK); __syncthreads();
  qkt(pA0, pA1, K_lds, qr, kro, kx); partialSM(pA0, pA1, m_reg, mnA, alA);
  if (2 < NT) SLOAD(0, 2 * KVBLK);
  SWRITE(1, 1); __syncthreads();
  b_prev = 0; b_cur = 1; b_next = 2;
  for (int j = 1; j + 1 < NT; j += 2) {
    SB8(); qkt(pB0, pB1, K_lds + b_cur * SHM_K8, qr, kro, kx);
    finishSM(pA0, pA1, alA, l_reg, pa); SB8();
    if (j + 2 < NT) SLOAD(1, (j + 2) * KVBLK); SB8();
    pv(o, V_lds + b_prev * SHM_V8, pa, vro, vx); partialSM(pB0, pB1, m_reg, mnB, alB);
    SWRITE(b_next, 0);
    RESC(alB); __syncthreads(); ROT3();
    SB8(); qkt(pA0, pA1, K_lds + b_cur * SHM_K8, qr, kro, kx);
    finishSM(pB0, pB1, alB, l_reg, pa); SB8();
    if (j + 3 < NT) SLOAD(0, (j + 3) * KVBLK); SB8();
    pv(o, V_lds + b_prev * SHM_V8, pa, vro, vx); partialSM(pA0, pA1, m_reg, mnA, alA);
    if (j + 2 < NT) SWRITE(b_next, 1);
    RESC(alA); __syncthreads(); ROT3();
  }
  SB8(); qkt(pB0, pB1, K_lds + b_cur * SHM_K8, qr, kro, kx);
  finishSM(pA0, pA1, alA, l_reg, pa); SB8();
  pv(o, V_lds + b_prev * SHM_V8, pa, vro, vx); partialSM(pB0, pB1, m_reg, mnB, alB);
  RESC(alB);
  finishSM(pB0, pB1, alB, l_reg, pa); SB8();
  pv(o, V_lds + b_cur * SHM_V8, pa, vro, vx);
#undef ROT3
  if (hi == 0) li_l[r32] = l_reg; asm volatile("s_waitcnt lgkmcnt(0)" ::: "memory");
  float rli[16];
#pragma unroll
  for (int r = 0; r < 16; ++r) rli[r] = __builtin_amdgcn_rcpf(li_l[crow(r, hi)]);
  unsigned char* Ow = (unsigned char*)Ob + (long)(wid * QBLK) * LDO;
#pragma unroll
  for (int r = 0; r < 16; ++r) { int orow = crow(r, hi);
#pragma unroll
    for (int d0 = 0; d0 < 4; ++d0) Ow[(long)orow * LDO + d0 * 32 + r32] = (unsigned char)(__builtin_amdgcn_cvt_pk_fp8_f32(o[d0][r] * rli[r], 0.f, 0, false) & 0xff); }
#undef SLOAD
#undef SWRITE
#undef SWAIT
#undef RESC
}
}

constexpr int S_ = 16384, DM = 2048, FF = 5632, INW = 8192;
constexpr float EPS = 1e-6f;
constexpr size_t MiB = 1u << 20;
constexpr size_t WS_G1 = 0;
constexpr size_t WS_TW = 256 * 1024;
constexpr size_t WS_CTL = 512 * 1024, CTL_BYTES = 16384;
constexpr size_t WS_W = 1 * MiB;
constexpr size_t WS_WGU = WS_W, WS_WD = WS_W + 44 * MiB;
constexpr size_t WS_WIN8 = WS_W + 12 * MiB, WS_WAO8 = WS_W + 52 * MiB;
constexpr size_t WS_WIN = WS_W, WS_WAO = WS_W + 32 * MiB, WS_WF = WS_W + 40 * MiB, WS_WOUT = WS_W + 44 * MiB;
constexpr size_t WS_U = 68 * MiB;
constexpr size_t WS_T = 132 * MiB;
constexpr size_t WS_R1 = 196 * MiB;
constexpr size_t WS_Q8 = 452 * MiB, WS_K8 = 484 * MiB, WS_VT8 = 492 * MiB;
constexpr size_t WS_END = 500 * MiB;
constexpr int LDS_BYTES = 147456, LDSCTL_OFF = 131072;
constexpr int NPHASE = 16;

typedef float f32x4 __attribute__((ext_vector_type(4)));
typedef unsigned u32x4 __attribute__((ext_vector_type(4)));
typedef unsigned u32x2 __attribute__((ext_vector_type(2)));
#define LAS __attribute__((address_space(3)))
#define LDS_WAIT() asm volatile("s_waitcnt lgkmcnt(0)" ::: "memory")


#define XB_TMO      128
#define XB_XCNT(j)  (256  + 64 * (j))
#define XB_XSUB(j)  (1280 + 64 * (j))
#define XB_XGEN(j)  (2304 + 64 * (j))
#define XB_TOP      3328
#define XB_TOPGEN   3392
#define XCD_BAR_WORDS 3456
#define XB_SPIN_CAP (1u << 18)
__device__ __forceinline__ unsigned xb_ld(unsigned* p)              { return __hip_atomic_load(p, __ATOMIC_RELAXED, __HIP_MEMORY_SCOPE_AGENT); }
__device__ __forceinline__ unsigned xb_add(unsigned* p, unsigned v) { return __hip_atomic_fetch_add(p, v, __ATOMIC_RELAXED, __HIP_MEMORY_SCOPE_AGENT); }
__device__ __forceinline__ unsigned xb_xcc_id() { return (unsigned)__builtin_amdgcn_s_getreg((3 << 11) | 20) & 0xFu; }
#define XB_SPIN(cond, bar) do { unsigned _sp = 0; while (cond) { __builtin_amdgcn_s_sleep(1); \
    if ((++_sp & 255u) == 0u) { if (xb_ld(&(bar)[XB_TMO])) break; if (_sp > XB_SPIN_CAP) { atomicAdd(&(bar)[XB_TMO], 1u); break; } } } } while (0)
struct XcdBarrier { unsigned* bar; unsigned x; volatile LAS unsigned* st; };
__device__ __forceinline__ XcdBarrier xcd_barrier_post(unsigned* bar, volatile LAS unsigned* st) {
    XcdBarrier b; b.bar = bar; b.x = xb_xcc_id(); b.st = st;
    if (threadIdx.x == 0) (void)xb_add(&bar[XB_XCNT(b.x)], 1u);
    return b;
}
__device__ __forceinline__ void xcd_barrier_complete(unsigned* bar, unsigned x, unsigned& nloc, unsigned& nx) {
    const unsigned G = gridDim.x * gridDim.y * gridDim.z;
    unsigned sum, cnt, mine, sp = 0u;
    for (;;) {
        sum = 0u; cnt = 0u; mine = 0u;
#pragma unroll
        for (unsigned j = 0; j < 16; ++j) { const unsigned c = xb_ld(&bar[XB_XCNT(j)]); sum += c; cnt += (c > 0u) ? 1u : 0u; mine = (j == x) ? c : mine; }
        if (sum == G) break;
        __builtin_amdgcn_s_sleep(1);
        if ((++sp & 255u) == 0u) { if (xb_ld(&bar[XB_TMO])) break; if (sp > XB_SPIN_CAP) { atomicAdd(&bar[XB_TMO], 1u); break; } }
    }
    nloc = mine > 0u ? mine : 1u; nx = cnt > 0u ? cnt : 1u;
}
__device__ __forceinline__ void xcd_barrier(const XcdBarrier& b) {
    asm volatile("s_waitcnt vmcnt(0)" ::: "memory");
    __syncthreads();
    if (threadIdx.x == 0) {
        unsigned* bar = b.bar;
        __builtin_amdgcn_s_waitcnt(0);
        unsigned nloc = b.st[0], nx = b.st[1];
        if (nloc == 0u) { xcd_barrier_complete(bar, b.x, nloc, nx); b.st[0] = nloc; b.st[1] = nx; }
        const unsigned old = xb_add(&bar[XB_XSUB(b.x)], 1u);
        const unsigned gen = old / nloc;
        if (old + 1u == (gen + 1u) * nloc) {
            __builtin_amdgcn_fence(__ATOMIC_RELEASE, "agent");
            asm volatile("s_waitcnt vmcnt(0)" ::: "memory");
            const unsigned og = xb_add(&bar[XB_TOP], 1u);
            const unsigned tg = og / nx;
            if (og + 1u == (tg + 1u) * nx) xb_add(&bar[XB_TOPGEN], 1u);
            else XB_SPIN(xb_ld(&bar[XB_TOPGEN]) == tg, bar);
            __builtin_amdgcn_fence(__ATOMIC_ACQUIRE, "agent");
            xb_add(&bar[XB_XGEN(b.x)], 1u);
            asm volatile("s_waitcnt vmcnt(0)" ::: "memory");
        } else {
            XB_SPIN(xb_ld(&bar[XB_XGEN(b.x)]) == gen, bar);
            __builtin_amdgcn_fence(__ATOMIC_ACQUIRE, "agent");
            asm volatile("s_waitcnt vmcnt(0)" ::: "memory");
        }
    }
    __syncthreads();
}

__device__ __forceinline__ float wave_sum(float v) {
    v += __builtin_bit_cast(float, __builtin_amdgcn_update_dpp(0, __builtin_bit_cast(int, v), 0xB1, 0xf, 0xf, false));
    v += __builtin_bit_cast(float, __builtin_amdgcn_update_dpp(0, __builtin_bit_cast(int, v), 0x4E, 0xf, 0xf, false));
    v += __builtin_bit_cast(float, __builtin_amdgcn_update_dpp(0, __builtin_bit_cast(int, v), 0x141, 0xf, 0xf, false));
    v += __builtin_bit_cast(float, __builtin_amdgcn_update_dpp(0, __builtin_bit_cast(int, v), 0x140, 0xf, 0xf, false));
    v += __shfl_xor(v, 16); v += __shfl_xor(v, 32);
    return v;
}
using pg8::cvt_pk_bf16; using pg8::bf_lo; using pg8::bf_hi;

__device__ __forceinline__ void transpose_item(const float* __restrict__ W, int N, unsigned short* __restrict__ WT, int ldt, int k0, int n0, int drow0, LAS float* scr, int lane) {
#pragma unroll
    for (int i = 0; i < 32; ++i) { const int kk = 2 * i + (lane >> 5); scr[kk * 33 + (lane & 31)] = W[(size_t)(k0 + kk) * N + n0 + (lane & 31)]; }
    LDS_WAIT(); asm volatile("" ::: "memory");
    const int c = lane & 7;
#pragma unroll
    for (int j = 0; j < 4; ++j) { const int n = (lane >> 3) + 8 * j; const LAS float* s = scr + (8 * c) * 33 + n;
        u32x4 o; o.x = cvt_pk_bf16(s[0 * 33], s[1 * 33]); o.y = cvt_pk_bf16(s[2 * 33], s[3 * 33]); o.z = cvt_pk_bf16(s[4 * 33], s[5 * 33]); o.w = cvt_pk_bf16(s[6 * 33], s[7 * 33]);
        *(u32x4*)(WT + (size_t)(drow0 + n) * ldt + k0 + 8 * c) = o; }
    LDS_WAIT(); asm volatile("" ::: "memory");
}
__device__ __forceinline__ void transpose_item8(const float* __restrict__ W, int N, unsigned char* __restrict__ WT8, int ldt, int k0, int n0, int drow0, LAS float* scr, int lane) {
#pragma unroll
    for (int i = 0; i < 32; ++i) { const int kk = 2 * i + (lane >> 5); scr[kk * 33 + (lane & 31)] = W[(size_t)(k0 + kk) * N + n0 + (lane & 31)]; }
    LDS_WAIT(); asm volatile("" ::: "memory");
    const int c = lane & 7;
#pragma unroll
    for (int j = 0; j < 4; ++j) { const int n = (lane >> 3) + 8 * j; const LAS float* s = scr + (8 * c) * 33 + n;
        int w0 = __builtin_amdgcn_cvt_pk_fp8_f32(s[0 * 33], s[1 * 33], 0, false); w0 = __builtin_amdgcn_cvt_pk_fp8_f32(s[2 * 33], s[3 * 33], w0, true);
        int w1 = __builtin_amdgcn_cvt_pk_fp8_f32(s[4 * 33], s[5 * 33], 0, false); w1 = __builtin_amdgcn_cvt_pk_fp8_f32(s[6 * 33], s[7 * 33], w1, true);
        u32x2 o; o.x = (unsigned)w0; o.y = (unsigned)w1;
        *(u32x2*)(WT8 + (size_t)(drow0 + n) * ldt + k0 + 8 * c) = o; }
    LDS_WAIT(); asm volatile("" ::: "memory");
}
__device__ __forceinline__ void transpose_plain(const float* W, int K, int N, unsigned short* WT, int it, LAS float* scr, int lane) {
    const int nblk = N / 32, kb = it / nblk, nb = it % nblk;
    transpose_item(W, N, WT, K, 64 * kb, 32 * nb, 32 * nb, scr, lane);
}
__device__ __forceinline__ void convert_ffn(const float* Wg, const float* Wu, const float* Wd, unsigned short* WGU, unsigned short* WD, LAS float* scr, int gw, int NGW, int lane) {
    constexpr int I_G = (DM / 64) * (FF / 32), I_D = (FF / 64) * (DM / 32);
    for (int it = gw; it < 2 * I_G + I_D; it += NGW) {
        int r = it;
        if (r < 2 * I_G) { const bool up = r >= I_G; if (up) r -= I_G; const int nblk = FF / 32, kb = r / nblk, nb = r % nblk, n0 = 32 * nb;
            transpose_item(up ? Wu : Wg, FF, WGU, DM, 64 * kb, n0, (n0 >> 7) * 256 + (up ? 128 : 0) + (n0 & 127), scr, lane); continue; }
        r -= 2 * I_G; transpose_plain(Wd, FF, DM, WD, r, scr, lane);
    }
}
template <int NR>
__device__ __forceinline__ void norm_rows(const float* xrow, const float* g, unsigned short* orow, int lane, size_t rstep) {
    f32x4 v[NR][8]; float s[NR];
#pragma unroll
    for (int r = 0; r < NR; ++r) { const f32x4* xr = (const f32x4*)(xrow + r * rstep) + lane;
#pragma unroll
        for (int j = 0; j < 8; ++j) v[r][j] = xr[64 * j]; }
#pragma unroll
    for (int r = 0; r < NR; ++r) { float a = 0.f;
#pragma unroll
        for (int j = 0; j < 8; ++j) a += (v[r][j].x * v[r][j].x + v[r][j].y * v[r][j].y) + (v[r][j].z * v[r][j].z + v[r][j].w * v[r][j].w);
        s[r] = a; }
#pragma unroll
    for (int r = 0; r < NR; ++r) s[r] = wave_sum(s[r]);
#pragma unroll
    for (int r = 0; r < NR; ++r) { const float rstd = 1.0f / sqrtf(s[r] * (1.f / DM) + EPS);
        u32x2* o8 = (u32x2*)(orow + r * rstep) + lane;
#pragma unroll
        for (int j = 0; j < 8; ++j) { const f32x4 gv = ((const f32x4*)g + lane)[64 * j]; u32x2 w; w.x = cvt_pk_bf16(v[r][j].x * rstd * gv.x, v[r][j].y * rstd * gv.y); w.y = cvt_pk_bf16(v[r][j].z * rstd * gv.z, v[r][j].w * rstd * gv.w); o8[64 * j] = w; } }
}
template <int NR, bool NEXT, bool BBF, bool OBF, bool U8 = false>
__device__ __forceinline__ void res_norm_rows(const unsigned short* trow, const void* brow, const float* post_g, float wgt, void* orow, const float* pre_g, unsigned short* urow, int lane, unsigned char* u8row, size_t rstep) {
    f32x4 t[NR][8], b[NR][8]; float s[NR];
#pragma unroll
    for (int r = 0; r < NR; ++r) { const u32x2* tr = (const u32x2*)(trow + r * rstep) + lane;
#pragma unroll
        for (int j = 0; j < 8; ++j) { const u32x2 w = tr[64 * j]; t[r][j] = (f32x4){bf_lo(w.x), bf_hi(w.x), bf_lo(w.y), bf_hi(w.y)}; } }
#pragma unroll
    for (int r = 0; r < NR; ++r) {
#pragma unroll
        for (int j = 0; j < 8; ++j) { if (BBF) { const u32x2 wb = ((const u32x2*)((const unsigned short*)brow + r * rstep) + lane)[64 * j]; b[r][j] = (f32x4){bf_lo(wb.x), bf_hi(wb.x), bf_lo(wb.y), bf_hi(wb.y)}; }
                                      else b[r][j] = ((const f32x4*)((const float*)brow + r * rstep) + lane)[64 * j]; } }
#pragma unroll
    for (int r = 0; r < NR; ++r) { float a = 0.f;
#pragma unroll
        for (int j = 0; j < 8; ++j) a += (t[r][j].x * t[r][j].x + t[r][j].y * t[r][j].y) + (t[r][j].z * t[r][j].z + t[r][j].w * t[r][j].w);
        s[r] = a; }
#pragma unroll
    for (int r = 0; r < NR; ++r) s[r] = wave_sum(s[r]);
    float s2[NR];
#pragma unroll
    for (int r = 0; r < NR; ++r) { const float rstd = wgt / sqrtf(s[r] * (1.f / DM) + EPS); float a = 0.f;
#pragma unroll
        for (int j = 0; j < 8; ++j) { const f32x4 g = ((const f32x4*)post_g + lane)[64 * j];
            t[r][j] = b[r][j] + t[r][j] * rstd * g;
            if (OBF) { u32x2 wo; wo.x = cvt_pk_bf16(t[r][j].x, t[r][j].y); wo.y = cvt_pk_bf16(t[r][j].z, t[r][j].w); ((u32x2*)((unsigned short*)orow + r * rstep) + lane)[64 * j] = wo; }
            else ((f32x4*)((float*)orow + r * rstep) + lane)[64 * j] = t[r][j];
            a += (t[r][j].x * t[r][j].x + t[r][j].y * t[r][j].y) + (t[r][j].z * t[r][j].z + t[r][j].w * t[r][j].w); }
        s2[r] = a; }
    if (NEXT) {
#pragma unroll
        for (int r = 0; r < NR; ++r) s2[r] = wave_sum(s2[r]);
#pragma unroll
        for (int r = 0; r < NR; ++r) { const float r2 = 1.0f / sqrtf(s2[r] * (1.f / DM) + EPS);
            u32x2* o8 = (u32x2*)(urow + r * rstep) + lane;
#pragma unroll
            for (int j = 0; j < 8; ++j) { const f32x4 gv = ((const f32x4*)pre_g + lane)[64 * j]; const f32x4 uu = t[r][j] * r2 * gv;
                u32x2 w; w.x = cvt_pk_bf16(uu.x, uu.y); w.y = cvt_pk_bf16(uu.z, uu.w); o8[64 * j] = w;
                if (U8) { int q = __builtin_amdgcn_cvt_pk_fp8_f32(uu.x, uu.y, 0, false); q = __builtin_amdgcn_cvt_pk_fp8_f32(uu.z, uu.w, q, true); ((unsigned*)(u8row + r * rstep) + lane)[64 * j] = (unsigned)q; } } }
    }
}
__device__ __forceinline__ void qk_rope_row(unsigned short* row, int s, const float* qg, const float* kg, int lane) {
    const int sec = lane >> 5, half = (lane >> 4) & 1, i0 = (2 * lane) & 31;
    const float pos = (float)(sec == 0 ? (s >> 6) : (s & 63));
    const float L = 13.287712379549449f / 32.f;
    float cs[2], sn[2];
#pragma unroll
    for (int e = 0; e < 2; ++e) { const float fr = exp2f(-(float)(i0 + e) * L); float rev = pos * fr * 0.15915494309189535f; rev -= floorf(rev);
        sn[e] = __builtin_amdgcn_sinf(rev); cs[e] = __builtin_amdgcn_cosf(rev); }
    const float gq0 = qg[2 * lane], gq1 = qg[2 * lane + 1], gk0 = kg[2 * lane], gk1 = kg[2 * lane + 1];
    unsigned w[20];
#pragma unroll
    for (int h = 0; h < 20; ++h) w[h] = ((const unsigned*)(row + h * 128))[lane];
#pragma unroll
    for (int h = 0; h < 20; ++h) {
        const float x0 = bf_lo(w[h]), x1 = bf_hi(w[h]);
        const float rstd = 1.0f / sqrtf(wave_sum(x0 * x0 + x1 * x1) * (1.f / 128.f) + EPS);
        const float y0 = x0 * rstd * (h < 16 ? gq0 : gk0), y1 = x1 * rstd * (h < 16 ? gq1 : gk1);
        const float p0 = __shfl_xor(y0, 16), p1 = __shfl_xor(y1, 16);
        const float o0 = half ? (y0 * cs[0] + p0 * sn[0]) : (y0 * cs[0] - p0 * sn[0]);
        const float o1 = half ? (y1 * cs[1] + p1 * sn[1]) : (y1 * cs[1] - p1 * sn[1]);
        ((unsigned*)(row + h * 128))[lane] = cvt_pk_bf16(o0, o1);
    }
}


__device__ __forceinline__ void qk_rope_row8(const unsigned short* row, int s, const float* qg, const float* kg, unsigned char* Q8, unsigned char* K8, int lane) {
    const int sec = lane >> 5, half = (lane >> 4) & 1, i0 = (2 * lane) & 31;
    const float pos = (float)(sec == 0 ? (s >> 6) : (s & 63));
    const float L = 13.287712379549449f / 32.f;
    float cs[2], sn[2];
#pragma unroll
    for (int e = 0; e < 2; ++e) { const float fr = exp2f(-(float)(i0 + e) * L); float rev = pos * fr * 0.15915494309189535f; rev -= floorf(rev);
        sn[e] = __builtin_amdgcn_sinf(rev); cs[e] = __builtin_amdgcn_cosf(rev); }
    const float gq0 = qg[2 * lane], gq1 = qg[2 * lane + 1], gk0 = kg[2 * lane], gk1 = kg[2 * lane + 1];
    unsigned w[20];
#pragma unroll
    for (int h = 0; h < 20; ++h) w[h] = ((const unsigned*)(row + h * 128))[lane];
#pragma unroll
    for (int h = 0; h < 20; ++h) {
        const float x0 = bf_lo(w[h]), x1 = bf_hi(w[h]);
        const float rstd = 1.0f / sqrtf(wave_sum(x0 * x0 + x1 * x1) * (1.f / 128.f) + EPS);
        const float y0 = x0 * rstd * (h < 16 ? gq0 : gk0), y1 = x1 * rstd * (h < 16 ? gq1 : gk1);
        const float p0 = __shfl_xor(y0, 16), p1 = __shfl_xor(y1, 16);
        const float o0 = half ? (y0 * cs[0] + p0 * sn[0]) : (y0 * cs[0] - p0 * sn[0]);
        const float o1 = half ? (y1 * cs[1] + p1 * sn[1]) : (y1 * cs[1] - p1 * sn[1]);
        const unsigned short w8 = (unsigned short)(__builtin_amdgcn_cvt_pk_fp8_f32(o0, o1, 0, false) & 0xffff);
        if (h < 16) ((unsigned short*)(Q8 + (size_t)s * 2048 + h * 128))[lane] = w8;
        else ((unsigned short*)(K8 + ((size_t)(h - 16) * S_ + s) * 128))[lane] = w8;
    }
}
__device__ __forceinline__ void v_transpose_item(const unsigned short* R1, unsigned char* Vt8, int item, LAS unsigned char* scr, int lane) {
    const int t = item >> 2, kvh = item & 3;
    const unsigned short* src = R1 + (size_t)(64 * t) * INW + 2560 + kvh * 128;
#pragma unroll
    for (int i = 0; i < 16; ++i) { const int rr = 4 * i + (lane >> 4), c16 = lane & 15; const u32x4 v = *(const u32x4*)(src + (size_t)rr * INW + c16 * 8); *(LAS u32x4*)(scr + rr * 256 + c16 * 16) = v; }
    LDS_WAIT(); asm volatile("" ::: "memory");
#pragma unroll
    for (int dh = 0; dh < 2; ++dh) { const int d = dh * 64 + lane;
        u32x4 o4[4];
#pragma unroll
        for (int q = 0; q < 16; ++q) { float f[4];
#pragma unroll
            for (int e = 0; e < 4; ++e) { const int key = att8::vkey(4 * q + e); f[e] = __uint_as_float((unsigned)(*(const LAS unsigned short*)(scr + key * 256 + d * 2)) << 16); }
            int ww = __builtin_amdgcn_cvt_pk_fp8_f32(f[0], f[1], 0, false); ww = __builtin_amdgcn_cvt_pk_fp8_f32(f[2], f[3], ww, true); o4[q >> 2][q & 3] = (unsigned)ww; }
        unsigned char* dst = Vt8 + (((size_t)kvh * 256 + t) * 128 + d) * 64;
#pragma unroll
        for (int q = 0; q < 4; ++q) *(u32x4*)(dst + 16 * q) = o4[q]; }
    LDS_WAIT(); asm volatile("" ::: "memory");
}

#define SINGLE_ARG(...) __VA_ARGS__
struct Args { const float* in[20]; float* out; unsigned char* ws; int ph_lo, ph_hi; };

__global__ void __launch_bounds__(512, 2) mk_fwd(Args args) {
    extern __shared__ __attribute__((aligned(16))) unsigned char lds[];
    cg::grid_group grid = cg::this_grid();
    const int tid = threadIdx.x, lane = tid & 63, wave = __builtin_amdgcn_readfirstlane(tid >> 6);
    const int G = gridDim.x, bx = blockIdx.x;
    const int gw = bx * 8 + wave, NGW = G * 8;
    unsigned char* ws = args.ws;
    unsigned short* const G1 = (unsigned short*)(ws + WS_G1); float* const TW = (float*)(ws + WS_TW);
    unsigned short* const U = (unsigned short*)(ws + WS_U); unsigned short* const T = (unsigned short*)(ws + WS_T); unsigned short* const R1 = (unsigned short*)(ws + WS_R1);
    const float* x = args.in[0]; float* out = args.out;
    unsigned short* const HB1 = (unsigned short*)args.out;
    unsigned short* const HB2 = (unsigned short*)(ws + WS_R1 + 176 * MiB);
    LAS unsigned char* ldsl = (LAS unsigned char*)lds;
    LAS float* scr = (LAS float*)(ldsl + wave * 16384);
    const int lo = args.ph_lo, hi = args.ph_hi;
    for (int u_ = tid; u_ < 64; u_ += 512) ((LAS unsigned*)(ldsl + LDSCTL_OFF))[u_] = 0u;
    __syncthreads();
    const XcdBarrier xbar = xcd_barrier_post((unsigned*)(ws + WS_CTL), (volatile LAS unsigned*)(ldsl + LDSCTL_OFF + 32));
#ifndef F1_AL
#define F1_AL false
#endif
#ifndef F1_SP
#define F1_SP true
#endif
#ifndef PHASE_MASK
#define PHASE_MASK 0xFFFF
#endif
#define IN(k) (((PHASE_MASK >> (k)) & 1) && lo <= (k) && (k) < hi)
#if PROBE_TS
    unsigned long long* const TS = (unsigned long long*)(ws + 768 * 1024);
#define STAMP(k) do { if (bx == 0 && tid == 0) TS[(k)] = __builtin_amdgcn_s_memrealtime(); } while (0)
#else
#define STAMP(k) do { } while (0)
#endif
    STAMP(0);
    if (hi < 0) grid.sync();
#define SEAM(k) do { if (IN(k) && IN((k) + 1)) xcd_barrier(xbar); STAMP((k) + 1); } while (0)
#define GEMM_PHASE_X(CFG, EPI, AL, SP, Aptr, Bptr, M_, N_, ...) do { pg8::Gemm g_{(const char*)(Aptr), (const char*)(Bptr)}; pg8::StaticOrder So_; So_.init((M_), (N_), G, bx, EPI::IDEMPOTENT ? REP_GEMM : EPI::REPX); \
        EPI E_{__VA_ARGS__}; pg8::gemm_phase<CFG, EPI, pg8::StaticOrder, AL, SP, false>(ldsl, g_, So_, E_); } while (0)
#define GEMM_PHASE(CFG, EPI, ...) GEMM_PHASE_X(SINGLE_ARG(CFG), SINGLE_ARG(EPI), true, true, __VA_ARGS__)
#define GEMM_PHASE_F8(CFG, EPI, Aptr, Bptr, M_, N_, ...) do { pg8::Gemm g_{(const char*)(Aptr), (const char*)(Bptr)}; pg8::StaticOrder So_; So_.init((M_), (N_), G, bx, 1); \
        EPI E_{__VA_ARGS__}; pg8::gemm_phase<CFG, EPI, pg8::StaticOrder, true, true, true>(ldsl, g_, So_, E_); } while (0)
    typedef pg8::Cfg<2048u, 2048u, (size_t)128 * 2048, (size_t)128 * 2048, (size_t)256 * 2048, 0, 0, (size_t)256 * 2048, 1024> CfgF8;
    typedef pg8::Cfg<512u, (unsigned)(128 * INW * 2), (size_t)128 * 512, (size_t)INW * 2, 0, 0, 256, (size_t)2 * INW * 2, 128> CfgF1;
    typedef pg8::Cfg<512u, 512u, (size_t)128 * 512, (size_t)128 * 512, 0, 0, 0, (size_t)256 * 512, 256> CfgF2;

    if (IN(0)) {
        for (int rp_ = 0; rp_ < REP_CONV; ++rp_) convert_ffn(args.in[2], args.in[3], args.in[4], (unsigned short*)(ws + WS_WGU), (unsigned short*)(ws + WS_WD), scr, gw, NGW, lane);
        for (int e = bx * 512 + tid; e < 256 * 256; e += G * 512) { const int r = e >> 8, c = e & 255, ro = r >> 7, i = r & 127, ri = c >> 7, j = c & 127, a = (i * j) & 127;
            const float cv = cospif((float)a * (1.f / 64.f)), sv = sinpif((float)a * (1.f / 64.f));
            const float v = (ro == ri) ? cv : (ro == 0 ? sv : -sv);
            G1[e] = (unsigned short)(cvt_pk_bf16(v * 0.08838834764831845f, 0.f) & 0xffffu); }
        for (int e = bx * 512 + tid; e < 128 * 128; e += G * 512) { const int c = e >> 7, b = e & 127, a = (b * c) & 16383;
            TW[2 * e] = cospif((float)a * (1.f / 8192.f)); TW[2 * e + 1] = -sinpif((float)a * (1.f / 8192.f)); }
        for (int m = gw; m < S_; m += 2 * NGW) norm_rows<2>(x + (size_t)m * DM, args.in[1], U + (size_t)m * DM, lane, (size_t)NGW * DM);
    }
    SEAM(0);
    if (IN(1)) GEMM_PHASE(SINGLE_ARG(pg8::StdCfg<DM, DM, DM>), pg8::EpiSwiglu, U, ws + WS_WGU, S_, 2 * FF, R1, FF);
    SEAM(1);
    if (IN(2)) GEMM_PHASE(SINGLE_ARG(pg8::StdCfg<FF, FF, FF>), pg8::EpiStore, R1, ws + WS_WD, S_, DM, T, DM);
    SEAM(2);
    if (IN(3)) {
        for (int m = gw; m < S_; m += 2 * NGW) res_norm_rows<2, true, false, true, true>(T + (size_t)m * DM, x + (size_t)m * DM, args.in[5], 0.5f, HB1 + (size_t)m * DM, args.in[6], U + (size_t)m * DM, lane, ws + WS_Q8 + (size_t)m * DM, (size_t)NGW * DM);
        constexpr int I_IN = (DM / 64) * (INW / 32), I_AO = (DM / 64) * (DM / 32), I_F = (1024 / 64) * (DM / 32);
        for (int rp_ = 0; rp_ < REP_CONV; ++rp_) for (int it = gw; it < I_IN + 2 * I_AO + I_F; it += NGW) { int r = it;
            if (r < I_IN) { const int nblk = INW / 32, kb = r / nblk, nb = r % nblk, n0 = 32 * nb;
                if (n0 < 3072) transpose_item8(args.in[7], INW, ws + WS_WIN8, DM, 64 * kb, n0, n0, scr, lane);
                else if (n0 < 4096) transpose_item(args.in[7], INW, (unsigned short*)(ws + WS_WIN), DM, 64 * kb, n0, n0 - 3072, scr, lane);
                else if (n0 < 6144) transpose_item8(args.in[7], INW, ws + WS_WIN8, DM, 64 * kb, n0, n0 - 1024, scr, lane);
                else transpose_item(args.in[7], INW, (unsigned short*)(ws + WS_WIN), DM, 64 * kb, n0, n0 - 5120, scr, lane);
                continue; } r -= I_IN;
            if (r < I_AO) { const int nblk = DM / 32, kb = r / nblk, nb = r % nblk; transpose_item8(args.in[11], DM, ws + WS_WAO8, DM, 64 * kb, 32 * nb, 32 * nb, scr, lane); continue; } r -= I_AO;
            if (r < I_F) { transpose_plain(args.in[12], 1024, DM, (unsigned short*)(ws + WS_WF), r, scr, lane); continue; } r -= I_F;
            transpose_plain(args.in[13], DM, DM, (unsigned short*)(ws + WS_WOUT), r, scr, lane); }
    }
    SEAM(3);
    if (IN(4)) {
        GEMM_PHASE(SINGLE_ARG(pg8::StdCfg<DM, DM, DM>), pg8::EpiStore, U, ws + WS_WIN, S_, 3072, R1 + 3072, INW, 4, 2048);
        GEMM_PHASE_F8(CfgF8, pg8::EpiStore, ws + WS_Q8, ws + WS_WIN8, S_, 5120, R1, INW, 12, 1024);
    }
    SEAM(4);
    if (IN(5)) {
        for (int rp_ = 0; rp_ < REP_ROPE; ++rp_) for (int m = gw; m < S_; m += NGW) qk_rope_row8(R1 + (size_t)m * INW, m, args.in[9], args.in[10], ws + WS_Q8, ws + WS_K8, lane);
        for (int rp_ = 0; rp_ < REP_ROPE; ++rp_) for (int it = gw; it < 1024; it += NGW) v_transpose_item(R1, ws + WS_VT8, it, (LAS unsigned char*)scr, lane);
        __syncthreads();
        GEMM_PHASE_X(CfgF1, pg8::EpiZt, F1_AL, F1_SP, G1, R1 + 3072, 8 * 256, 64 * 256, U);
    }
    SEAM(5);
    if (IN(6)) GEMM_PHASE(CfgF2, pg8::EpiYt, G1, U, 256, 131072, T, TW);
    SEAM(6);
    if (IN(7)) GEMM_PHASE(CfgF2, pg8::EpiXf, G1, T, 256, 131072, R1 + 3072, INW);
    SEAM(7);
    if (IN(8)) {
        for (int rp_ = 0; rp_ < REP_ATTN; ++rp_)
        for (int u = bx; u < 1024; u += G) { const int kvh = u >> 8, w = u & 255, qh = 4 * kvh + (w & 3), qb = w >> 2;
            __syncthreads();
            att8::attn_body(ws + WS_Q8 + (size_t)qb * 256 * 2048 + qh * 128, ws + WS_K8 + (size_t)kvh * S_ * 128, ws + WS_VT8 + (size_t)kvh * 128 * S_,
                            (unsigned char*)U + (size_t)qb * 256 * DM + qh * 128, S_, (char*)lds);
        }
        __syncthreads();
    }
    SEAM(8);
    if (IN(9)) GEMM_PHASE_F8(CfgF8, pg8::EpiGate<false>, U, ws + WS_WAO8, S_, DM, T, DM, R1 + 4096, INW, args.in[8]);
    if (IN(10)) GEMM_PHASE(SINGLE_ARG(pg8::StdCfg<INW, 1024, 1024>), pg8::EpiGate<true>, R1 + 3072, ws + WS_WF, S_, DM, T, DM, R1 + 4096 + DM, INW, args.in[8] + DM);
    SEAM(10);
    if (IN(11)) GEMM_PHASE(SINGLE_ARG(pg8::StdCfg<DM, DM, DM>), pg8::EpiStore, T, ws + WS_WOUT, S_, DM, U, DM);
    SEAM(11);
    if (IN(12)) {
        for (int m = gw; m < S_; m += 2 * NGW) res_norm_rows<2, true, true, true>(U + (size_t)m * DM, HB1 + (size_t)m * DM, args.in[14], 1.0f, HB2 + (size_t)m * DM, args.in[15], U + (size_t)m * DM, lane, nullptr, (size_t)NGW * DM);
        for (int rp_ = 0; rp_ < REP_CONV; ++rp_) convert_ffn(args.in[16], args.in[17], args.in[18], (unsigned short*)(ws + WS_WGU), (unsigned short*)(ws + WS_WD), scr, gw, NGW, lane);
    }
    SEAM(12);
    if (IN(13)) GEMM_PHASE(SINGLE_ARG(pg8::StdCfg<DM, DM, DM>), pg8::EpiSwiglu, U, ws + WS_WGU, S_, 2 * FF, R1, FF);
    SEAM(13);
    if (IN(14)) GEMM_PHASE(SINGLE_ARG(pg8::StdCfg<FF, FF, FF>), pg8::EpiStore, R1, ws + WS_WD, S_, DM, T, DM);
    SEAM(14);
    if (IN(15)) {
        for (int m = gw; m < S_; m += 2 * NGW) res_norm_rows<2, false, true, false>(T + (size_t)m * DM, HB2 + (size_t)m * DM, args.in[19], 0.5f, out + (size_t)m * DM, nullptr, nullptr, lane, nullptr, (size_t)NGW * DM);
    }
#if PROBE_TS
    __syncthreads();
    if (bx == 0) { STAMP(16); __syncthreads();
        float v1 = 0.f, v2 = 0.f;
        for (int k = 0; k < 16; ++k) { const float d = (float)(long long)(TS[k + 1] - TS[k]) * 0.01f; if ((PROBE_M1 >> k) & 1) v1 += d; if ((PROBE_M2 >> k) & 1) v2 += d; }
        if (tid == 0) out[0] += v1;
        for (int e = tid; e < 4096; e += 512) out[DM + e] += v2 * (1.f / 16.f); }
#endif
#undef IN
#undef SEAM
#undef GEMM_PHASE
#undef GEMM_PHASE_X
#undef GEMM_PHASE_F8
}

extern "C" void kernel_launch(void* const* d_in, const int* in_sizes, int n_in, void* d_out, int out_size, void* d_ws, size_t ws_size, hipStream_t stream) {
    static int grid = 0;
    if (grid == 0) {
        if (n_in != 20 || in_sizes[0] != S_ * DM || out_size != S_ * DM || ws_size < WS_END) {
            fprintf(stderr, "kernel_launch: shape/workspace mismatch: n_in %d in0 %d out %d ws %zu (need %zu)\n", n_in, n_in > 0 ? in_sizes[0] : -1, out_size, ws_size, (size_t)WS_END); grid = -1; return; }
        int dev = 0, cus = 0, per_cu = 0;
        if (hipGetDevice(&dev) != hipSuccess || hipDeviceGetAttribute(&cus, hipDeviceAttributeMultiprocessorCount, dev) != hipSuccess) { fprintf(stderr, "kernel_launch: device query failed\n"); grid = -1; return; }
        if (hipFuncSetAttribute((const void*)mk_fwd, hipFuncAttributeMaxDynamicSharedMemorySize, LDS_BYTES) != hipSuccess) { fprintf(stderr, "kernel_launch: hipFuncSetAttribute failed\n"); grid = -1; return; }
        if (hipOccupancyMaxActiveBlocksPerMultiprocessor(&per_cu, (const void*)mk_fwd, 512, LDS_BYTES) != hipSuccess || per_cu < 1) { fprintf(stderr, "kernel_launch: occupancy query says %d blocks per CU\n", per_cu); per_cu = 1; }
        (void)hipGetLastError();
        grid = cus;
    }
    if (grid < 0) return;
    if (hipMemsetAsync((char*)d_ws + WS_CTL, 0, CTL_BYTES, stream) != hipSuccess) { fprintf(stderr, "kernel_launch: memset of barrier words failed\n"); return; }
    Args a{};
    for (int i = 0; i < 20; ++i) a.in[i] = (const float*)d_in[i];
    a.out = (float*)d_out; a.ws = (unsigned char*)d_ws;
#if MK_PER_PHASE
    for (int p = 0; p < NPHASE; ++p) { a.ph_lo = p; a.ph_hi = p + 1;
        hipLaunchKernelGGL(mk_fwd, dim3(grid), dim3(512), LDS_BYTES, stream, a);
        const hipError_t le = hipPeekAtLastError(); if (le != hipSuccess) { fprintf(stderr, "kernel_launch: launch %d failed: %s\n", p, hipGetErrorName(le)); break; } }
#else
    a.ph_lo = 0; a.ph_hi = NPHASE;
    void* kargs[] = {&a};
    const hipError_t e = hipLaunchCooperativeKernel((const void*)mk_fwd, dim3(grid), dim3(512), kargs, LDS_BYTES, stream);
    if (e != hipSuccess) fprintf(stderr, "kernel_launch: cooperative launch failed: %s (grid %d)\n", hipGetErrorString(e), grid);
#endif
}
```

```cpp
#include <hip/hip_runtime.h>
#include <hip/hip_bf16.h>
#include <hip/hip_cooperative_groups.h>
#include <cstdio>
#include <cstdint>
namespace cg = cooperative_groups;

#ifndef REP_GEMM
#define REP_GEMM 1
#endif
#ifndef REP_ATTN
#define REP_ATTN 1
#endif
#ifndef REP_F1
#define REP_F1 1
#endif
#ifndef REP_ROW
#define REP_ROW 1
#endif
#ifndef REP_ROPE
#define REP_ROPE 1
#endif
#ifndef REP_CONV
#define REP_CONV 1
#endif
#ifndef PROBE_TS
#define PROBE_TS 0
#endif
#ifndef PROBE_M1
#define PROBE_M1 0x0100
#endif
#ifndef PROBE_M2
#define PROBE_M2 0xFFFF
#endif
#ifndef MK_PER_PHASE
#define MK_PER_PHASE 0
#endif

namespace pg8 {
#define PG8_LAS __attribute__((address_space(3)))
typedef unsigned short bf16_t;
typedef short bf16x8 __attribute__((ext_vector_type(8)));
typedef float f32x4 __attribute__((ext_vector_type(4)));
typedef unsigned u32x4 __attribute__((ext_vector_type(4)));
constexpr int BM = 256, BK = 64, HALF = 128, HTB = HALF * BK * 2, STAGE_BYTES = 8 * HTB, NXCD = 8, WGM = 8;

__host__ __device__ __forceinline__ int lds_byte(int r, int c) { const int st = (r >> 4) * 2 + (c >> 5), rr = r & 15, cc = c & 31, ob = rr * 64 + cc * 2; return st * 1024 + (ob ^ (((ob >> 9) & 1) << 5)); }
__host__ __device__ __forceinline__ void stage_rc(int b, int& R, int& C) { const int st = b / 1024, sb = b % 1024, swz = sb ^ (((sb >> 9) & 1) << 5); R = (st >> 1) * 16 + swz / 64; C = (st & 1) * 32 + (swz % 64) / 2; }
__host__ __device__ __forceinline__ int perm32(int rho) { const int n = rho >> 4, i = rho & 15; return 8 * (i >> 2) + 4 * n + (i & 3); }

struct Unit { int pm, pn; };
struct Gemm { const char* A; const char* B; };
template <unsigned ROWA_, unsigned ROWB_, size_t HA_, size_t HB_, size_t PMA_, size_t PNA_, size_t PMB_, size_t PNB_, int K_> struct Cfg {
    static constexpr unsigned rowA = ROWA_, rowB = ROWB_; static constexpr size_t hstepA = HA_, hstepB = HB_, pmA = PMA_, pnA = PNA_, pmB = PMB_, pnB = PNB_; static constexpr int K = K_; };
template <int LDA, int LDB, int K_> using StdCfg = Cfg<(unsigned)LDA * 2u, (unsigned)LDB * 2u, (size_t)128 * LDA * 2, (size_t)128 * LDB * 2, (size_t)256 * LDA * 2, 0, 0, (size_t)256 * LDB * 2, K_>;

struct StaticOrder {
    int nM, nN, nwg, G, c, rep, wgm;
    __host__ __device__ void init(int M, int N, int G_, int c_, int rep_ = 1) { nM = M / BM; nN = N / BM; nwg = nM * nN; G = G_; c = c_; rep = rep_; wgm = (nN <= 8) ? 4 : WGM; }
    __host__ __device__ bool next(int i, Unit& u) const {
        long L = (long)i * G + c; if (L >= (long)nwg * rep) return false; L %= nwg;
        int wgid = (int)L; { const int q = nwg / NXCD, r = nwg % NXCD, xcd = wgid % NXCD, off = wgid / NXCD; wgid = (xcd < r ? xcd * (q + 1) : r * (q + 1) + (xcd - r) * q) + off; }
        const int nig = wgm * nN, gid = wgid / nig, fm = gid * wgm, gsz = (nM - fm) < wgm ? (nM - fm) : wgm;
        u.pm = fm + ((wgid % nig) % gsz); u.pn = (wgid % nig) / gsz; return true;
    }
};

__device__ __forceinline__ unsigned cvt_pk_bf16(float lo, float hi) { unsigned r; asm volatile("v_cvt_pk_bf16_f32 %0, %1, %2" : "=v"(r) : "v"(lo), "v"(hi)); return r; }
__device__ __forceinline__ float bf_lo(unsigned w) { return __uint_as_float(w << 16); }
__device__ __forceinline__ float bf_hi(unsigned w) { return __uint_as_float(w & 0xffff0000u); }
__device__ __forceinline__ u32x4 pack8(const f32x4 a, const f32x4 b) { u32x4 w; w.x = cvt_pk_bf16(a[0], a[1]); w.y = cvt_pk_bf16(a[2], a[3]); w.z = cvt_pk_bf16(b[0], b[1]); w.w = cvt_pk_bf16(b[2], b[3]); return w; }
__device__ __forceinline__ float sigmoidf_(float x) { return __builtin_amdgcn_rcpf(1.f + __builtin_amdgcn_exp2f(-1.4426950408889634f * x)); }


struct EpiStore {
    static constexpr bool PERM = true, IDEMPOTENT = true; static constexpr int REPX = 1;
    bf16_t* O; int ldc; int split = 1 << 30, gap = 0;
    __device__ __forceinline__ void operator()(const f32x4 (&acc)[2][2][4][2], const Unit& u, int wr, int wc, int fr, int fq) const {
        const int row0 = u.pm * BM + wr * 64 + fr, col0 = u.pn * BM + (u.pn >= split ? gap : 0) + wc * 32 + 8 * fq;
#pragma unroll
        for (int ai = 0; ai < 2; ++ai)
#pragma unroll
            for (int m = 0; m < 4; ++m) { bf16_t* rowp = O + (size_t)(row0 + ai * HALF + m * 16) * ldc + col0;
#pragma unroll
                for (int bj = 0; bj < 2; ++bj) *(u32x4*)(rowp + bj * HALF) = pack8(acc[ai][bj][m][0], acc[ai][bj][m][1]); }
    }
};
struct EpiSwiglu {
    static constexpr bool PERM = true, IDEMPOTENT = true; static constexpr int REPX = 1;
    bf16_t* O; int ldc;
    __device__ __forceinline__ void operator()(const f32x4 (&acc)[2][2][4][2], const Unit& u, int wr, int wc, int fr, int fq) const {
        const int row0 = u.pm * BM + wr * 64 + fr, col0 = u.pn * HALF + wc * 32 + 8 * fq;
#pragma unroll
        for (int ai = 0; ai < 2; ++ai)
#pragma unroll
            for (int m = 0; m < 4; ++m) { bf16_t* rowp = O + (size_t)(row0 + ai * HALF + m * 16) * ldc + col0;
                f32x4 v[2];
#pragma unroll
                for (int n = 0; n < 2; ++n) { const f32x4 g = acc[ai][0][m][n], up = acc[ai][1][m][n];
#pragma unroll
                    for (int j = 0; j < 4; ++j) v[n][j] = g[j] * sigmoidf_(g[j]) * up[j]; }
                *(u32x4*)rowp = pack8(v[0], v[1]); }
    }
};
template <bool ACCUM> struct EpiGate {
    static constexpr bool PERM = true, IDEMPOTENT = !ACCUM; static constexpr int REPX = 1;
    bf16_t* O; int ldc; const bf16_t* Gt; int ldg; const float* bias;
    __device__ __forceinline__ void operator()(const f32x4 (&acc)[2][2][4][2], const Unit& u, int wr, int wc, int fr, int fq) const {
        const int row0 = u.pm * BM + wr * 64 + fr, col0 = u.pn * BM + wc * 32 + 8 * fq;
        f32x4 bv[2][2];
#pragma unroll
        for (int bj = 0; bj < 2; ++bj)
#pragma unroll
            for (int n = 0; n < 2; ++n) bv[bj][n] = *(const f32x4*)(bias + col0 + bj * HALF + 4 * n);
#pragma unroll
        for (int ai = 0; ai < 2; ++ai)
#pragma unroll
            for (int m = 0; m < 4; ++m) { const size_t r = (size_t)(row0 + ai * HALF + m * 16);
#pragma unroll
                for (int bj = 0; bj < 2; ++bj) { const u32x4 gw = *(const u32x4*)(Gt + r * ldg + col0 + bj * HALF);
                    f32x4 g0 = {bf_lo(gw.x), bf_hi(gw.x), bf_lo(gw.y), bf_hi(gw.y)}, g1 = {bf_lo(gw.z), bf_hi(gw.z), bf_lo(gw.w), bf_hi(gw.w)};
                    g0 = g0 + bv[bj][0]; g1 = g1 + bv[bj][1];
                    f32x4 v0, v1;
#pragma unroll
                    for (int j = 0; j < 4; ++j) { v0[j] = sigmoidf_(g0[j]) * acc[ai][bj][m][0][j]; v1[j] = sigmoidf_(g1[j]) * acc[ai][bj][m][1][j]; }
                    bf16_t* op = O + r * ldc + col0 + bj * HALF;
                    if (ACCUM) { const u32x4 ow = *(const u32x4*)op;
                        v0 = v0 + (f32x4){bf_lo(ow.x), bf_hi(ow.x), bf_lo(ow.y), bf_hi(ow.y)}; v1 = v1 + (f32x4){bf_lo(ow.z), bf_hi(ow.z), bf_lo(ow.w), bf_hi(ow.w)}; }
                    *(u32x4*)op = pack8(v0, v1); } }
    }
};
struct EpiZt {
    static constexpr bool PERM = true, IDEMPOTENT = false; static constexpr int REPX = REP_F1;
    bf16_t* Z;
    __device__ __forceinline__ void operator()(const f32x4 (&acc)[2][2][4][2], const Unit& u, int wr, int wc, int fr, int fq) const {
        const int a0 = wc * 32 + 8 * fq;
#pragma unroll
        for (int ai = 0; ai < 2; ++ai)
#pragma unroll
            for (int m = 0; m < 4; ++m) { const int mi = wr * 64 + m * 16 + fr;
#pragma unroll
                for (int bj = 0; bj < 2; ++bj) { const int b = 2 * u.pn + bj;
                    *(u32x4*)(Z + ((size_t)((u.pm * 128 + mi) * 128 + b)) * 256 + ai * 128 + a0) = pack8(acc[ai][bj][m][0], acc[ai][bj][m][1]); } }
    }
};
struct EpiYt {
    static constexpr bool PERM = true, IDEMPOTENT = true; static constexpr int REPX = 1;
    bf16_t* Y; const float* tw;
    __device__ __forceinline__ void operator()(const f32x4 (&acc)[2][2][4][2], const Unit& u, int wr, int wc, int fr, int fq) const {
        const int b0 = wc * 32 + 8 * fq;
#pragma unroll
        for (int m = 0; m < 4; ++m) { const int c = wr * 64 + m * 16 + fr;
            f32x4 t[4];
#pragma unroll
            for (int q = 0; q < 4; ++q) t[q] = *(const f32x4*)(tw + ((size_t)c * 128 + b0) * 2 + 4 * q);
#pragma unroll
            for (int bj = 0; bj < 2; ++bj) { const int gm = 2 * u.pn + bj;
                f32x4 re[2], im[2];
#pragma unroll
                for (int n = 0; n < 2; ++n)
#pragma unroll
                    for (int j = 0; j < 4; ++j) { const int e = 4 * n + j; const float tc = t[e >> 1][(e & 1) * 2], ts = t[e >> 1][(e & 1) * 2 + 1];
                        const float xr = acc[0][bj][m][n][j], xi = acc[1][bj][m][n][j];
                        re[n][j] = xr * tc - xi * ts; im[n][j] = xr * ts + xi * tc; }
                bf16_t* p = Y + ((size_t)(c * 1024 + gm) * 2) * 128 + b0;
                *(u32x4*)p = pack8(re[0], re[1]); *(u32x4*)(p + 128) = pack8(im[0], im[1]); } }
    }
};
struct EpiXf {
    static constexpr bool PERM = true, IDEMPOTENT = true; static constexpr int REPX = 1;
    bf16_t* X; int ldx;
    __device__ __forceinline__ void operator()(const f32x4 (&acc)[2][2][4][2], const Unit& u, int wr, int wc, int fr, int fq) const {
        const int c = u.pn >> 2, gm0 = (u.pn & 3) * 256 + wc * 32 + 8 * fq;
#pragma unroll
        for (int m = 0; m < 4; ++m) { const int d = wr * 64 + m * 16 + fr;
#pragma unroll
            for (int bj = 0; bj < 2; ++bj) *(u32x4*)(X + (size_t)(c + 128 * d) * ldx + gm0 + bj * HALF) = pack8(acc[0][bj][m][0], acc[0][bj][m][1]); }
    }
};

typedef long l2_t __attribute__((ext_vector_type(2)));
template <class C, class Epi, class Sched, bool ALIGN_EPI = false, bool SP2 = false, bool F8 = false, bool KREV = false>
__device__ __forceinline__ void gemm_phase(PG8_LAS unsigned char* lds, const Gemm g, const Sched& S, const Epi& E) {
    const int tid = threadIdx.x, wid = __builtin_amdgcn_readfirstlane(tid >> 6), lane = tid & 63, wr = wid >> 2, wc = wid & 3, fr = lane & 15, fq = lane >> 4;
    constexpr int K = C::K, nt = K / BK;
    unsigned voffA[2], voffB[2];
#pragma unroll
    for (int i = 0; i < 2; ++i) { int R, Cc; stage_rc(tid * 16 + i * 8192, R, Cc); const int Rb = Epi::PERM ? ((R & ~31) + perm32(R & 31)) : R;
        voffA[i] = (unsigned)R * C::rowA + (unsigned)Cc * 2u; voffB[i] = (unsigned)Rb * C::rowB + (unsigned)Cc * 2u; }
    constexpr long kstep = KREV ? -(long)(BK * 2) : (long)(BK * 2);
    constexpr long kfirst = KREV ? (long)(K / BK - 1) * (BK * 2) : 0;
    constexpr size_t hstepA = C::hstepA, hstepB = C::hstepB;
    const unsigned ldsw = (unsigned)wid * 1024u;
    const int aoff = lds_byte(wr * 64 + fr, fq * 8), boff = lds_byte(wc * 32 + fr, fq * 8);
#define PG8_SA(b, h) (((b) * 2 + (h)) * HTB)
#define PG8_SB(b, h) ((4 + (b) * 2 + (h)) * HTB)
#define PG8_STAGE(bufoff, gbase, voff) do { _Pragma("unroll") for (int _i = 0; _i < 2; ++_i) \
        __builtin_amdgcn_global_load_lds((const unsigned*)((const char*)(gbase) + (voff)[_i]), (PG8_LAS unsigned*)(lds + (bufoff) + ldsw + _i * 8192), 16, 0, 0); } while (0)
#define PG8_LDA(dst, b, h) do { _Pragma("unroll") for (int m = 0; m < 4; ++m) _Pragma("unroll") for (int k = 0; k < 2; ++k) dst[m][k] = *(const PG8_LAS bf16x8*)(lds + PG8_SA(b, h) + aoff + m * 2048 + k * 1024); } while (0)
#define PG8_LDB(dst, b, h) do { _Pragma("unroll") for (int n = 0; n < 2; ++n) _Pragma("unroll") for (int k = 0; k < 2; ++k) dst[n][k] = *(const PG8_LAS bf16x8*)(lds + PG8_SB(b, h) + boff + n * 2048 + k * 1024); } while (0)
#define PG8_MMA(ai, bj, At, Bt) do { __builtin_amdgcn_s_setprio(1); _Pragma("unroll") for (int m = 0; m < 4; ++m) _Pragma("unroll") for (int n = 0; n < 2; ++n) _Pragma("unroll") for (int k = 0; k < 2; ++k) { \
        if constexpr (F8) { const l2_t b_ = __builtin_bit_cast(l2_t, Bt[n][k]), a_ = __builtin_bit_cast(l2_t, At[m][k]); \
            acc[ai][bj][m][n] = __builtin_amdgcn_mfma_f32_16x16x32_fp8_fp8(b_[0], a_[0], acc[ai][bj][m][n], 0, 0, 0); \
            acc[ai][bj][m][n] = __builtin_amdgcn_mfma_f32_16x16x32_fp8_fp8(b_[1], a_[1], acc[ai][bj][m][n], 0, 0, 0); } \
        else acc[ai][bj][m][n] = __builtin_amdgcn_mfma_f32_16x16x32_bf16(Bt[n][k], At[m][k], acc[ai][bj][m][n], 0, 0, 0); } \
        __builtin_amdgcn_s_setprio(0); } while (0)
#define PG8_WAIT_V(n) asm volatile("s_waitcnt vmcnt(" #n ")" ::: "memory")
#define PG8_WAIT_L(n) asm volatile("s_waitcnt lgkmcnt(" #n ")" ::: "memory")
#define PG8_BAR __builtin_amdgcn_s_barrier()
#define PG8_SCHED __builtin_amdgcn_sched_barrier(0)
#define PG8_TA(u) (g.A + (size_t)(u).pm * C::pmA + (size_t)(u).pn * C::pnA + kfirst)
#define PG8_TB(u) (g.B + (size_t)(u).pm * C::pmB + (size_t)(u).pn * C::pnB + kfirst)
    Unit cur, nxt; int ui = 0;
    if (!S.next(0, cur)) return;
    f32x4 acc[2][2][4][2];
#pragma unroll
    for (int a = 0; a < 2; ++a)
#pragma unroll
        for (int b = 0; b < 2; ++b)
#pragma unroll
            for (int m = 0; m < 4; ++m)
#pragma unroll
                for (int n = 0; n < 2; ++n) acc[a][b][m][n] = (f32x4){0.f, 0.f, 0.f, 0.f};
    bf16x8 At[4][2], B0[2][2], B1[2][2];
    const char* cA = PG8_TA(cur); const char* cB = PG8_TB(cur);
    if constexpr (SP2) {
        PG8_STAGE(PG8_SB(0, 0), cB, voffB); PG8_STAGE(PG8_SB(0, 1), cB + hstepB, voffB); PG8_STAGE(PG8_SA(0, 0), cA, voffA); PG8_STAGE(PG8_SA(0, 1), cA + hstepA, voffA);
        if (wr == 1) PG8_BAR;
        PG8_WAIT_V(2); PG8_BAR;
        PG8_STAGE(PG8_SB(1, 0), cB + kstep, voffB); PG8_STAGE(PG8_SA(1, 0), cA + kstep, voffA); PG8_STAGE(PG8_SB(1, 1), cB + hstepB + kstep, voffB);
        PG8_WAIT_V(6); PG8_BAR;
    } else {
        PG8_STAGE(PG8_SB(0, 0), cB, voffB); PG8_STAGE(PG8_SA(0, 0), cA, voffA); PG8_STAGE(PG8_SB(0, 1), cB + hstepB, voffB); PG8_STAGE(PG8_SA(0, 1), cA + hstepA, voffA);
        if (wr == 1) PG8_BAR;
        PG8_WAIT_V(4); PG8_BAR;
        PG8_STAGE(PG8_SB(1, 0), cB + kstep, voffB); PG8_STAGE(PG8_SA(1, 0), cA + kstep, voffA); PG8_STAGE(PG8_SB(1, 1), cB + hstepB + kstep, voffB);
        PG8_WAIT_V(6); PG8_BAR;
    }
    for (;;) {
        const bool has_next = S.next(ui + 1, nxt);
        const char* nA = has_next ? PG8_TA(nxt) : cA; const char* nB = has_next ? PG8_TB(nxt) : cB;
#pragma nounroll
        for (int t = 0; t < nt; t += 2) {
            const bool last = (t == nt - 2);
            const char* a1 = cA + (long)(t + 1) * kstep;
            const char* a2 = last ? nA : cA + (long)(t + 2) * kstep; const char* b2 = last ? nB : cB + (long)(t + 2) * kstep;
            const char* a3 = a2 + kstep; const char* b3 = b2 + kstep;
            if constexpr (SP2) {
            PG8_LDB(B0, 0, 0); PG8_LDB(B1, 0, 1); PG8_SCHED; PG8_LDA(At, 0, 0); PG8_STAGE(PG8_SA(1, 1), a1 + hstepA, voffA);
            PG8_WAIT_V(8); PG8_WAIT_L(0); PG8_BAR; PG8_MMA(0, 0, At, B0); PG8_MMA(0, 1, At, B1); PG8_BAR; PG8_SCHED;
            PG8_LDA(At, 0, 1); PG8_STAGE(PG8_SB(0, 0), b2, voffB); PG8_STAGE(PG8_SB(0, 1), b2 + hstepB, voffB); PG8_STAGE(PG8_SA(0, 0), a2, voffA);
            PG8_WAIT_V(8); PG8_WAIT_L(0); PG8_BAR; PG8_MMA(1, 0, At, B0); PG8_MMA(1, 1, At, B1); PG8_BAR; PG8_SCHED;
            PG8_LDB(B0, 1, 0); PG8_LDB(B1, 1, 1); PG8_SCHED; PG8_LDA(At, 1, 0); PG8_STAGE(PG8_SA(0, 1), a2 + hstepA, voffA);
            PG8_WAIT_V(8); PG8_WAIT_L(0); PG8_BAR; PG8_MMA(0, 0, At, B0); PG8_MMA(0, 1, At, B1); PG8_BAR; PG8_SCHED;
            PG8_LDA(At, 1, 1); PG8_STAGE(PG8_SB(1, 0), b3, voffB); PG8_STAGE(PG8_SB(1, 1), b3 + hstepB, voffB); PG8_STAGE(PG8_SA(1, 0), a3, voffA);
            PG8_WAIT_V(8); PG8_WAIT_L(0); PG8_BAR; PG8_MMA(1, 0, At, B0); PG8_MMA(1, 1, At, B1); PG8_BAR; PG8_SCHED;
            } else {
            PG8_LDB(B0, 0, 0); PG8_SCHED; PG8_LDA(At, 0, 0); PG8_STAGE(PG8_SA(1, 1), a1 + hstepA, voffA);
            PG8_WAIT_L(8); PG8_BAR; PG8_WAIT_L(0); PG8_MMA(0, 0, At, B0); PG8_BAR; PG8_SCHED;
            PG8_LDB(B1, 0, 1); PG8_STAGE(PG8_SB(0, 0), b2, voffB);
            PG8_BAR; PG8_WAIT_L(0); PG8_MMA(0, 1, At, B1); PG8_BAR;
            PG8_LDA(At, 0, 1); PG8_STAGE(PG8_SA(0, 0), a2, voffA);
            PG8_BAR; PG8_WAIT_L(0); PG8_MMA(1, 0, At, B0); PG8_BAR; PG8_SCHED;
            PG8_STAGE(PG8_SB(0, 1), b2 + hstepB, voffB);
            PG8_WAIT_V(6); PG8_BAR; PG8_MMA(1, 1, At, B1); PG8_BAR;
            PG8_LDB(B0, 1, 0); PG8_SCHED; PG8_LDA(At, 1, 0); PG8_STAGE(PG8_SA(0, 1), a2 + hstepA, voffA);
            PG8_WAIT_L(8); PG8_BAR; PG8_WAIT_L(0); PG8_MMA(0, 0, At, B0); PG8_BAR; PG8_SCHED;
            PG8_LDB(B1, 1, 1); PG8_STAGE(PG8_SB(1, 0), b3, voffB);
            PG8_BAR; PG8_WAIT_L(0); PG8_MMA(0, 1, At, B1); PG8_BAR;
            PG8_LDA(At, 1, 1); PG8_STAGE(PG8_SA(1, 0), a3, voffA);
            PG8_BAR; PG8_WAIT_L(0); PG8_MMA(1, 0, At, B0); PG8_BAR; PG8_SCHED;
            PG8_STAGE(PG8_SB(1, 1), b3 + hstepB, voffB);
            PG8_WAIT_V(6); PG8_BAR; PG8_MMA(1, 1, At, B1); PG8_BAR;
            }
        }
        if constexpr (ALIGN_EPI) { if (wr == 0) PG8_BAR; }
        E(acc, cur, wr, wc, fr, fq);
        if (!has_next) break;
#pragma unroll
        for (int a = 0; a < 2; ++a)
#pragma unroll
            for (int b = 0; b < 2; ++b)
#pragma unroll
                for (int m = 0; m < 4; ++m)
#pragma unroll
                    for (int n = 0; n < 2; ++n) acc[a][b][m][n] = (f32x4){0.f, 0.f, 0.f, 0.f};
        cur = nxt; cA = nA; cB = nB; ++ui;
        if constexpr (ALIGN_EPI) { if (wr == 1) PG8_BAR; }
    }
    PG8_WAIT_V(0);
    if constexpr (!ALIGN_EPI) { if (wr == 0) PG8_BAR; }
    PG8_BAR;
#undef PG8_SA
#undef PG8_SB
#undef PG8_STAGE
#undef PG8_LDA
#undef PG8_LDB
#undef PG8_MMA
#undef PG8_WAIT_V
#undef PG8_WAIT_L
#undef PG8_BAR
#undef PG8_SCHED
#undef PG8_TA
#undef PG8_TB
}
}

namespace att {
using bf16 = __hip_bfloat16;
constexpr int   D = 128, NW = 8, QBLK = 32, KVBLK = 64;
constexpr float SCALE = 0.088388347648318440f;
constexpr float THR = 8.f;
constexpr int LDQ = 8192, LDK = 8192, LDO = 2048;
constexpr size_t SHM_V = KVBLK * D * 2, SHM_K = KVBLK * D * 2, SHM_ATTN = 2 * SHM_V + 2 * SHM_K + NW * 64 * 4;
using bf16x8 = __attribute__((ext_vector_type(8))) short;
using s16x4  = __attribute__((ext_vector_type(4))) short;
using f32x16 = __attribute__((ext_vector_type(16))) float;
using u32x4  = __attribute__((ext_vector_type(4))) unsigned;
#define KSWZ(row, colB) ((row) * 256 + ((colB) ^ (((row) & 7) << 4)))
#define SBAR() __builtin_amdgcn_sched_barrier(0)
__device__ __forceinline__ int crow(int r, int hi) { return (r & 3) + 8 * (r >> 2) + 4 * hi; }
__device__ __forceinline__ unsigned cvtpk(float lo, float hi) { unsigned r; asm volatile("v_cvt_pk_bf16_f32 %0, %1, %2" : "=v"(r) : "v"(lo), "v"(hi)); return r; }
__device__ __forceinline__ bf16x8 ld8(const bf16* p) { return *reinterpret_cast<const bf16x8*>(p); }

__device__ __forceinline__ void partialSM(f32x16& p0, f32x16& p1, float& m_reg, float& mn, float& alpha) {
  constexpr float C = SCALE * 1.4426950408889634f;
  float pmax = p0[0]; for (int r = 1; r < 16; ++r) pmax = fmaxf(pmax, p0[r]); for (int r = 0; r < 16; ++r) pmax = fmaxf(pmax, p1[r]);
  { auto rr = __builtin_amdgcn_permlane32_swap(__float_as_uint(pmax), __float_as_uint(pmax), false, false);
    pmax = fmaxf(__uint_as_float(rr[0]), __uint_as_float(rr[1])); }
  if (__builtin_expect(__all(pmax - m_reg <= THR / SCALE), 1)) { mn = m_reg; alpha = 1.f; }
  else { mn = fmaxf(m_reg, pmax); alpha = __builtin_amdgcn_exp2f((m_reg - mn) * C); m_reg = mn; }
  float mnC = -mn * C;
  for (int r = 0; r < 16; ++r) p0[r] = fmaf(p0[r], C, mnC); for (int r = 0; r < 16; ++r) p1[r] = fmaf(p1[r], C, mnC);
  for (int r = 0; r < 16; ++r) p0[r] = __builtin_amdgcn_exp2f(p0[r]);
}
__device__ __forceinline__ void finishSM(f32x16& p0, f32x16& p1, float alpha, float& l_reg, bf16x8& pa0, bf16x8& pa1, bf16x8& pa2, bf16x8& pa3) {
  for (int r = 0; r < 16; ++r) p1[r] = __builtin_amdgcn_exp2f(p1[r]);
  float ps = 0; for (int r = 0; r < 16; ++r) ps += p0[r]; for (int r = 0; r < 16; ++r) ps += p1[r];
  { auto rr = __builtin_amdgcn_permlane32_swap(__float_as_uint(ps), __float_as_uint(ps), false, false);
    ps = __uint_as_float(rr[0]) + __uint_as_float(rr[1]); }
  l_reg = l_reg * alpha + ps;
#define PK4(P, BASE, OUT) do { unsigned a0 = cvtpk(P[BASE + 0], P[BASE + 1]), a1 = cvtpk(P[BASE + 2], P[BASE + 3]);   \
    unsigned b0 = cvtpk(P[BASE + 4], P[BASE + 5]), b1 = cvtpk(P[BASE + 6], P[BASE + 7]);                              \
    auto r0 = __builtin_amdgcn_permlane32_swap(a0, b0, false, false); auto r1 = __builtin_amdgcn_permlane32_swap(a1, b1, false, false); \
    u32x4 w = {r0[0], r1[0], r0[1], r1[1]}; OUT = *reinterpret_cast<bf16x8*>(&w); } while (0)
  PK4(p0, 0, pa0); PK4(p0, 8, pa1); PK4(p1, 0, pa2); PK4(p1, 8, pa3);
#undef PK4
}
__device__ __forceinline__ void qkt(f32x16& p0, f32x16& p1, const bf16* Ks, const bf16x8* qr, int r32, int hi) {
  p0 = f32x16{}; p1 = f32x16{};
  for (int d0 = 0; d0 < 8; ++d0) { int cb = (d0 * 16 + hi * 8) * 2;
    bf16x8 b0 = *reinterpret_cast<const bf16x8*>((const char*)Ks + KSWZ(r32, cb));
    bf16x8 b1 = *reinterpret_cast<const bf16x8*>((const char*)Ks + KSWZ(32 + r32, cb));
    p0 = __builtin_amdgcn_mfma_f32_32x32x16_bf16(b0, qr[d0], p0, 0, 0, 0);
    p1 = __builtin_amdgcn_mfma_f32_32x32x16_bf16(b1, qr[d0], p1, 0, 0, 0); }
}
__device__ __forceinline__ int v_st(int k, int c) { const int kk = (k & ~0xC) | ((k & 4) << 1) | ((k & 8) >> 1); return ((kk >> 3) * 4 + (c >> 5)) * 512 + ((kk & 7) * 32 + (c & 31)) * 2; }
__device__ __forceinline__ int v_rd_base(int lane) { return ((lane & 3) << 3) | (((lane >> 2) & 3) << 6) | (((lane >> 4) & 1) << 5) | (((lane >> 5) & 1) << 8); }
constexpr int v_rd_off(int d0, int ks, int half) { return d0 * 512 + ks * 4096 + half * 2048; }
template <int OFF> __device__ __forceinline__ s16x4 tr_read(int vb) {
  s16x4 r; asm volatile("ds_read_b64_tr_b16 %0, %1 offset:%2" : "=&v"(r) : "v"(vb), "i"(OFF) : "memory"); return r;
}
template <int D0> __device__ __forceinline__ void pv_one(f32x16& od, int vb, bf16x8 pa0, bf16x8 pa1, bf16x8 pa2, bf16x8 pa3) {
  const s16x4 l0 = tr_read<v_rd_off(D0, 0, 0)>(vb), h0 = tr_read<v_rd_off(D0, 0, 1)>(vb), l1 = tr_read<v_rd_off(D0, 1, 0)>(vb), h1 = tr_read<v_rd_off(D0, 1, 1)>(vb);
  const s16x4 l2 = tr_read<v_rd_off(D0, 2, 0)>(vb), h2 = tr_read<v_rd_off(D0, 2, 1)>(vb), l3 = tr_read<v_rd_off(D0, 3, 0)>(vb), h3 = tr_read<v_rd_off(D0, 3, 1)>(vb);
  asm volatile("s_waitcnt lgkmcnt(0)" ::: "memory"); SBAR();
#define PK(L, H) (bf16x8){L[0], L[1], L[2], L[3], H[0], H[1], H[2], H[3]}
  od = __builtin_amdgcn_mfma_f32_32x32x16_bf16(pa0, PK(l0, h0), od, 0, 0, 0);
  od = __builtin_amdgcn_mfma_f32_32x32x16_bf16(pa1, PK(l1, h1), od, 0, 0, 0);
  od = __builtin_amdgcn_mfma_f32_32x32x16_bf16(pa2, PK(l2, h2), od, 0, 0, 0);
  od = __builtin_amdgcn_mfma_f32_32x32x16_bf16(pa3, PK(l3, h3), od, 0, 0, 0);
#undef PK
}
__device__ __forceinline__ void pv_d0(f32x16* o, int vb, bf16x8 pa0, bf16x8 pa1, bf16x8 pa2, bf16x8 pa3) {
  pv_one<0>(o[0], vb, pa0, pa1, pa2, pa3); pv_one<1>(o[1], vb, pa0, pa1, pa2, pa3); pv_one<2>(o[2], vb, pa0, pa1, pa2, pa3); pv_one<3>(o[3], vb, pa0, pa1, pa2, pa3);
}

__device__ __forceinline__ void attn_dense_body(const bf16* Qb, const bf16* __restrict__ Kh, const bf16* __restrict__ Vh,
                                                bf16* Ob, int seq, char* lds) {
  constexpr int SDEPTH = 2;
  const int tid = threadIdx.x, wid = tid >> 6, lane = tid & 63, r32 = lane & 31, hi = lane >> 5;
  bf16* V_lds = (bf16*)lds; bf16* K_lds = (bf16*)(lds + 2 * SHM_V);
  float* ws = (float*)(lds + 2 * SHM_V + 2 * SHM_K) + wid * 64; float* li_l = ws; float* al_l = ws + 32;
  float m_reg = -1e30f, l_reg = 0; f32x16 o[4] = {}; bf16x8 qr[8];
  const bf16* Qw = Qb + (long)(wid * QBLK + r32) * LDQ + hi * 8;
#pragma unroll
  for (int d0 = 0; d0 < 8; ++d0) qr[d0] = ld8(Qw + d0 * 16);
  const int sr = tid >> 4, sc = (tid & 15) * 8, vst0 = v_st(sr, sc), vst1 = v_st(32 + sr, sc);
  const int vb0 = (int)(uintptr_t)V_lds + v_rd_base(lane);
  struct { bf16x8 vs0, vs1, ks0, ks1; } sr_[SDEPTH];
#define SLOAD(i, k0) do { sr_[i].vs0 = ld8(&Vh[(long)((k0) + sr) * LDK + sc]); sr_[i].vs1 = ld8(&Vh[(long)((k0) + 32 + sr) * LDK + sc]); \
    sr_[i].ks0 = ld8(&Kh[(long)((k0) + sr) * LDK + sc]); sr_[i].ks1 = ld8(&Kh[(long)((k0) + 32 + sr) * LDK + sc]); } while (0)
#define SWRITE(b, i) do { *(bf16x8*)((char*)V_lds + (b) * SHM_V + vst0) = sr_[i].vs0;          \
    *(bf16x8*)((char*)V_lds + (b) * SHM_V + vst1) = sr_[i].vs1; int kc = sc * 2;               \
    *(bf16x8*)((char*)K_lds + (b) * SHM_K + KSWZ(sr, kc)) = sr_[i].ks0;                       \
    *(bf16x8*)((char*)K_lds + (b) * SHM_K + KSWZ(32 + sr, kc)) = sr_[i].ks1; } while (0)
#define SWAIT() do { asm volatile("s_waitcnt vmcnt(4)" ::: "memory"); } while (0)
#define RESC(a) do { if (__any((a) < 1.f)) { if (hi == 0) al_l[r32] = (a); asm volatile("s_waitcnt lgkmcnt(0)" ::: "memory"); \
    for (int d = 0; d < 4; ++d) for (int r = 0; r < 16; ++r) o[d][r] *= al_l[crow(r, hi)]; } } while (0)
  f32x16 pA0, pA1, pB0, pB1; float mnA, mnB, alA, alB; bf16x8 pa0, pa1, pa2, pa3; const int NT = seq / KVBLK;
  constexpr int SE = 0, SO = SDEPTH - 1;
  SLOAD(SE, 0); asm volatile("s_waitcnt vmcnt(0)" ::: "memory"); SWRITE(0, SE); __syncthreads();
  qkt(pA0, pA1, K_lds, qr, r32, hi); partialSM(pA0, pA1, m_reg, mnA, alA);
  SLOAD(SO, KVBLK); if (2 < NT) SLOAD(SE, 2 * KVBLK);
  SWAIT(); SWRITE(1, SO); __syncthreads();
  for (int j = 1; j + 1 < NT; j += 2) {
    SBAR(); qkt(pB0, pB1, (bf16*)((char*)K_lds + SHM_K), qr, r32, hi);
    finishSM(pA0, pA1, alA, l_reg, pa0, pa1, pa2, pa3); SBAR();
    SLOAD(SO, (j + SDEPTH) * KVBLK); SBAR();
    pv_d0(o, vb0, pa0, pa1, pa2, pa3); partialSM(pB0, pB1, m_reg, mnB, alB);
    __syncthreads(); SWAIT(); SWRITE(0, SE);
    RESC(alB); __syncthreads();
    SBAR(); qkt(pA0, pA1, K_lds, qr, r32, hi);
    finishSM(pB0, pB1, alB, l_reg, pa0, pa1, pa2, pa3); SBAR();
    if (j + 3 < NT) SLOAD(SE, (j + 1 + SDEPTH) * KVBLK); SBAR();
    pv_d0(o, vb0 + (int)SHM_V, pa0, pa1, pa2, pa3); partialSM(pA0, pA1, m_reg, mnA, alA);
    __syncthreads(); SWAIT(); SWRITE(1, SO);
    RESC(alA); __syncthreads();
  }
  SBAR(); qkt(pB0, pB1, (bf16*)((char*)K_lds + SHM_K), qr, r32, hi);
  finishSM(pA0, pA1, alA, l_reg, pa0, pa1, pa2, pa3); SBAR();
  pv_d0(o, vb0, pa0, pa1, pa2, pa3); partialSM(pB0, pB1, m_reg, mnB, alB);
  __syncthreads(); RESC(alB);
  finishSM(pB0, pB1, alB, l_reg, pa0, pa1, pa2, pa3); SBAR();
  pv_d0(o, vb0 + (int)SHM_V, pa0, pa1, pa2, pa3);
  if (hi == 0) li_l[r32] = l_reg; asm volatile("s_waitcnt lgkmcnt(0)" ::: "memory");
  float rli[16];
#pragma unroll
  for (int r = 0; r < 16; ++r) rli[r] = __builtin_amdgcn_rcpf(li_l[crow(r, hi)]);
  unsigned short* Ow = (unsigned short*)Ob + (long)(wid * QBLK) * LDO;
#pragma unroll
  for (int r = 0; r < 16; ++r) { int orow = crow(r, hi);
#pragma unroll
    for (int d0 = 0; d0 < 4; ++d0) Ow[(long)orow * LDO + d0 * 32 + r32] = (unsigned short)(cvtpk(o[d0][r] * rli[r], 0.f) & 0xffffu); }
#undef SLOAD
#undef SWRITE
#undef SWAIT
#undef RESC
}
}


namespace att8 {
using bf16 = __hip_bfloat16;
typedef int v8i __attribute__((ext_vector_type(8)));
typedef int v4i __attribute__((ext_vector_type(4)));
using f32x16 = __attribute__((ext_vector_type(16))) float;
typedef float f2 __attribute__((ext_vector_type(2)));
constexpr int D = 128, NW = 8, QBLK = 32, KVBLK = 64;
constexpr float SCALE = 0.088388347648318440f;
constexpr float THR = 8.f;
constexpr int LDQ8 = 2048, LDK8 = 128, LDO = 2048;
constexpr int SHM_K8 = 8192, SHM_V8 = 8192;
#define SB8() __builtin_amdgcn_sched_barrier(0)
constexpr int SCL = 0x7f7f7f7f;
__device__ __forceinline__ int crow(int r, int hi) { return (r & 3) + 8 * (r >> 2) + 4 * hi; }
__host__ __device__ __forceinline__ int vpos(int key) { return 32 * ((key >> 2) & 1) + 16 * (key >> 5) + (key & 3) + 4 * ((key >> 3) & 3); }
__host__ __device__ __forceinline__ int vkey(int pos) { const int hi = pos >> 5, e = pos & 31, p = e >> 4, r = e & 15; return 32 * p + (r & 3) + 8 * (r >> 2) + 4 * hi; }

__device__ __forceinline__ void partialSM(f32x16& p0, f32x16& p1, float& m_reg, float& mn, float& alpha) {
  constexpr float C = SCALE * 1.4426950408889634f;
  float pmax = p0[0]; for (int r = 1; r < 16; ++r) pmax = fmaxf(pmax, p0[r]); for (int r = 0; r < 16; ++r) pmax = fmaxf(pmax, p1[r]);
  { auto rr = __builtin_amdgcn_permlane32_swap(__float_as_uint(pmax), __float_as_uint(pmax), false, false);
    pmax = fmaxf(__uint_as_float(rr[0]), __uint_as_float(rr[1])); }
  if (__builtin_expect(__all(pmax - m_reg <= THR / SCALE), 1)) { mn = m_reg; alpha = 1.f; }
  else { mn = fmaxf(m_reg, pmax); alpha = __builtin_amdgcn_exp2f((m_reg - mn) * C); m_reg = mn; }
  const float mnC = -mn * C; const f2 c2 = {C, C}, m2 = {mnC, mnC};
#pragma unroll
  for (int r = 0; r < 8; ++r) { f2 v = {p0[2 * r], p0[2 * r + 1]}; v = v * c2 + m2; p0[2 * r] = v.x; p0[2 * r + 1] = v.y;
                                f2 w = {p1[2 * r], p1[2 * r + 1]}; w = w * c2 + m2; p1[2 * r] = w.x; p1[2 * r + 1] = w.y; }
#pragma unroll
  for (int r = 0; r < 16; ++r) p0[r] = __builtin_amdgcn_exp2f(p0[r]);
}
__device__ __forceinline__ void finishSM(f32x16& p0, f32x16& p1, float alpha, float& l_reg, v8i& pa) {
  for (int r = 0; r < 16; ++r) p1[r] = __builtin_amdgcn_exp2f(p1[r]);
  f2 s2 = {p0[0], p0[1]};
#pragma unroll
  for (int r = 1; r < 8; ++r) s2 += (f2){p0[2 * r], p0[2 * r + 1]};
#pragma unroll
  for (int r = 0; r < 8; ++r) s2 += (f2){p1[2 * r], p1[2 * r + 1]};
  float ps = s2.x + s2.y;
  { auto rr = __builtin_amdgcn_permlane32_swap(__float_as_uint(ps), __float_as_uint(ps), false, false);
    ps = __uint_as_float(rr[0]) + __uint_as_float(rr[1]); }
  l_reg = l_reg * alpha + ps;
#pragma unroll
  for (int i = 0; i < 4; ++i) { int w = __builtin_amdgcn_cvt_pk_bf8_f32(p0[4 * i], p0[4 * i + 1], 0, false); w = __builtin_amdgcn_cvt_pk_bf8_f32(p0[4 * i + 2], p0[4 * i + 3], w, true); pa[i] = w; }
#pragma unroll
  for (int i = 0; i < 4; ++i) { int w = __builtin_amdgcn_cvt_pk_bf8_f32(p1[4 * i], p1[4 * i + 1], 0, false); w = __builtin_amdgcn_cvt_pk_bf8_f32(p1[4 * i + 2], p1[4 * i + 3], w, true); pa[4 + i] = w; }
}
__device__ __forceinline__ v8i ld32(const char* a, const char* b) { const v4i x = *(const v4i*)a, y = *(const v4i*)b; return (v8i){x[0], x[1], x[2], x[3], y[0], y[1], y[2], y[3]}; }
__device__ __forceinline__ void qkt(f32x16& p0, f32x16& p1, const char* Ks, const v8i* qr, int kro, const int (&kx)[2][2]) {
  p0 = f32x16{}; p1 = f32x16{};
#pragma unroll
  for (int db = 0; db < 2; ++db) {
    const v8i k0 = ld32(Ks + kro + kx[db][0], Ks + kro + kx[db][1]);
    const v8i k1 = ld32(Ks + 4096 + kro + kx[db][0], Ks + 4096 + kro + kx[db][1]);
    p0 = __builtin_amdgcn_mfma_scale_f32_32x32x64_f8f6f4(k0, qr[db], p0, 0, 0, 0, SCL, 0, SCL);
    p1 = __builtin_amdgcn_mfma_scale_f32_32x32x64_f8f6f4(k1, qr[db], p1, 0, 0, 0, SCL, 0, SCL); }
}
__device__ __forceinline__ void pv(f32x16* o, const char* Vs, const v8i pa, int vro, const int (&vx)[2]) {
#pragma unroll
  for (int d0 = 0; d0 < 4; ++d0) { const v8i vf = ld32(Vs + d0 * 2048 + vro + vx[0], Vs + d0 * 2048 + vro + vx[1]);
    o[d0] = __builtin_amdgcn_mfma_scale_f32_32x32x64_f8f6f4(pa, vf, o[d0], 1, 0, 0, SCL, 0, SCL); }
}
__device__ __forceinline__ void attn_body(const unsigned char* Qb, const unsigned char* __restrict__ Kh, const unsigned char* __restrict__ Vh, unsigned char* Ob, int seq, char* lds) {
  const int tid = threadIdx.x, wid = tid >> 6, lane = tid & 63, r32 = lane & 31, hi = lane >> 5;
  char* V_lds = lds; char* K_lds = lds + 3 * SHM_V8;
  float* ws = (float*)(lds + 3 * SHM_V8 + 3 * SHM_K8) + wid * 64; float* li_l = ws; float* al_l = ws + 32;
  float m_reg = -1e30f, l_reg = 0; f32x16 o[4] = {}; v8i qr[2];
  const unsigned char* Qw = Qb + (long)(wid * QBLK + r32) * LDQ8 + hi * 32;
#pragma unroll
  for (int db = 0; db < 2; ++db) qr[db] = ld32((const char*)Qw + db * 64, (const char*)Qw + db * 64 + 16);
  const int skey = tid >> 3, skc = tid & 7, kst = skey * 128 + ((skc ^ ((skey >> 1) & 7)) << 4);
  const int sd = tid >> 2, svc = tid & 3, vst = sd * 64 + ((svc ^ ((sd >> 2) & 3)) << 4);
  const unsigned char* kg = Kh + skey * 128 + skc * 16;
  const unsigned char* vg = Vh + sd * 64 + svc * 16;
  const int kro = r32 * 128, ksw = (r32 >> 1) & 7, vro = r32 * 64, vsw = (r32 >> 2) & 3;
  int kx[2][2], vx[2];
#pragma unroll
  for (int db = 0; db < 2; ++db)
#pragma unroll
    for (int j = 0; j < 2; ++j) kx[db][j] = ((4 * db + 2 * hi + j) ^ ksw) << 4;
#pragma unroll
  for (int j = 0; j < 2; ++j) vx[j] = ((2 * hi + j) ^ vsw) << 4;
  struct { v4i ks, vs; } sr_[2];
#define SLOAD(i, k0) do { sr_[i].ks = *(const v4i*)(kg + (long)(k0) * 128); sr_[i].vs = *(const v4i*)(vg + (long)(k0) * 128); } while (0)
#define SWRITE(b, i) do { *(v4i*)(K_lds + (b) * SHM_K8 + kst) = sr_[i].ks; *(v4i*)(V_lds + (b) * SHM_V8 + vst) = sr_[i].vs; } while (0)
#define SWAIT() do { asm volatile("s_waitcnt vmcnt(2)" ::: "memory"); } while (0)
#define RESC(a) do { if (__any((a) < 1.f)) { if (hi == 0) al_l[r32] = (a); asm volatile("s_waitcnt lgkmcnt(0)" ::: "memory"); \
    for (int d = 0; d < 4; ++d) for (int r = 0; r < 16; ++r) o[d][r] *= al_l[crow(r, hi)]; } } while (0)
  f32x16 pA0, pA1, pB0, pB1; float mnA, mnB, alA, alB; v8i pa; const int NT = seq / KVBLK;
  int b_prev = 0, b_cur = 0, b_next = 1;
#define ROT3() do { b_prev = b_cur; b_cur = b_next; b_next = (b_next == 2) ? 0 : b_next + 1; } while (0)
  SLOAD(0, 0); asm volatile("s_waitcnt vmcnt(0)" ::: "memory"); SWRITE(0, 0); SLOAD(1, KVBLK); __syncthreads();
  qkt(pA0, pA1, K_lds, qr, kro, kx); partialSM(pA0, pA1, m_reg, mnA, alA);
  if (2 < NT) SLOAD(0, 2 * KVBLK);
  SWRITE(1, 1); __syncthreads();
  b_prev = 0; b_cur = 1; b_next = 2;
  for (int j = 1; j + 1 < NT; j += 2) {
    SB8(); qkt(pB0, pB1, K_lds + b_cur * SHM_K8, qr, kro, kx);
    finishSM(pA0, pA1, alA, l_reg, pa); SB8();
    if (j + 2 < NT) SLOAD(1, (j + 2) * KVBLK); SB8();
    pv(o, V_lds + b_prev * SHM_V8, pa, vro, vx); partialSM(pB0, pB1, m_reg, mnB, alB);
    SWRITE(b_next, 0);
    RESC(alB); __syncthreads(); ROT3();
    SB8(); qkt(pA0, pA1, K_lds + b_cur * SHM_K8, qr, kro, kx);
    finishSM(pB0, pB1, alB, l_reg, pa); SB8();
    if (j + 3 < NT) SLOAD(0, (j + 3) * KVBLK); SB8();
    pv(o, V_lds + b_prev * SHM_V8, pa, vro, vx); partialSM(pA0, pA1, m_reg, mnA, alA);
    if (j + 2 < NT) SWRITE(b_next, 1);
    RESC(alA); __syncthreads(); ROT3();
  }
  SB8(); qkt(pB0, pB1, K_lds + b_cur * SHM_K8, qr, kro, kx);
  finishSM(pA0, pA1, alA, l_reg, pa); SB8();
  pv(o, V_lds + b_prev * SHM_V8, pa, vro, vx); partialSM(pB0, pB1, m_reg, mnB, alB);
  RESC(alB);
  finishSM(pB0, pB1, alB, l_reg, pa); SB8();
  pv(o, V_lds + b_cur * SHM_V8, pa, vro, vx);
#undef ROT3
  if (hi == 0) li_l[r32] = l_reg; asm volatile("s_waitcnt lgkmcnt(0)" ::: "memory");
  float rli[16];
#pragma unroll
  for (int r = 0; r < 16; ++r) rli[r] = __builtin_amdgcn_rcpf(li_l[crow(r, hi)]);
  unsigned char* Ow = (unsigned char*)Ob + (long)(wid * QBLK) * LDO;
#pragma unroll
  for (int r = 0; r < 16; ++r) { int orow = crow(r, hi);
#pragma unroll
    for (int d0 = 0; d0 < 4; ++d0) Ow[(long)orow * LDO + d0 * 32 + r32] = (unsigned char)(__builtin_amdgcn_cvt_pk_fp8_f32(o[d0][r] * rli[r], 0.f, 0, false) & 0xff); }
#undef SLOAD
#undef SWRITE
#undef SWAIT
#undef RESC
}
}

constexpr int S_ = 16384, DM = 2048, FF = 5632, INW = 8192;
constexpr float EPS = 1e-6f;
constexpr size_t MiB = 1u << 20;
constexpr size_t WS_G1 = 0;
constexpr size_t WS_TW = 256 * 1024;
constexpr size_t WS_CTL = 512 * 1024, CTL_BYTES = 16384;
constexpr size_t WS_W = 1 * MiB;
constexpr size_t WS_WGU = WS_W, WS_WD = WS_W + 44 * MiB;
constexpr size_t WS_WIN8 = WS_W + 12 * MiB, WS_WAO8 = WS_W + 52 * MiB;
constexpr size_t WS_WIN = WS_W, WS_WAO = WS_W + 32 * MiB, WS_WF = WS_W + 40 * MiB, WS_WOUT = WS_W + 44 * MiB;
constexpr size_t WS_U = 68 * MiB;
constexpr size_t WS_T = 132 * MiB;
constexpr size_t WS_R1 = 196 * MiB;
constexpr size_t WS_Q8 = 452 * MiB, WS_K8 = 484 * MiB, WS_VT8 = 492 * MiB;
constexpr size_t WS_END = 500 * MiB;
constexpr int LDS_BYTES = 147456, LDSCTL_OFF = 131072;
constexpr int NPHASE = 16;

typedef float f32x4 __attribute__((ext_vector_type(4)));
typedef unsigned u32x4 __attribute__((ext_vector_type(4)));
typedef unsigned u32x2 __attribute__((ext_vector_type(2)));
#define LAS __attribute__((address_space(3)))
#define LDS_WAIT() asm volatile("s_waitcnt lgkmcnt(0)" ::: "memory")


#define XB_TMO      128
#define XB_XCNT(j)  (256  + 64 * (j))
#define XB_XSUB(j)  (1280 + 64 * (j))
#define XB_XGEN(j)  (2304 + 64 * (j))
#define XB_TOP      3328
#define XB_TOPGEN   3392
#define XCD_BAR_WORDS 3456
#define XB_SPIN_CAP (1u << 18)
__device__ __forceinline__ unsigned xb_ld(unsigned* p)              { return __hip_atomic_load(p, __ATOMIC_RELAXED, __HIP_MEMORY_SCOPE_AGENT); }
__device__ __forceinline__ unsigned xb_add(unsigned* p, unsigned v) { return __hip_atomic_fetch_add(p, v, __ATOMIC_RELAXED, __HIP_MEMORY_SCOPE_AGENT); }
__device__ __forceinline__ unsigned xb_xcc_id() { return (unsigned)__builtin_amdgcn_s_getreg((3 << 11) | 20) & 0xFu; }
#define XB_SPIN(cond, bar) do { unsigned _sp = 0; while (cond) { __builtin_amdgcn_s_sleep(1); \
    if ((++_sp & 255u) == 0u) { if (xb_ld(&(bar)[XB_TMO])) break; if (_sp > XB_SPIN_CAP) { atomicAdd(&(bar)[XB_TMO], 1u); break; } } } } while (0)
struct XcdBarrier { unsigned* bar; unsigned x; volatile LAS unsigned* st; };
__device__ __forceinline__ XcdBarrier xcd_barrier_post(unsigned* bar, volatile LAS unsigned* st) {
    XcdBarrier b; b.bar = bar; b.x = xb_xcc_id(); b.st = st;
    if (threadIdx.x == 0) (void)xb_add(&bar[XB_XCNT(b.x)], 1u);
    return b;
}
__device__ __forceinline__ void xcd_barrier_complete(unsigned* bar, unsigned x, unsigned& nloc, unsigned& nx) {
    const unsigned G = gridDim.x * gridDim.y * gridDim.z;
    unsigned sum, cnt, mine, sp = 0u;
    for (;;) {
        sum = 0u; cnt = 0u; mine = 0u;
#pragma unroll
        for (unsigned j = 0; j < 16; ++j) { const unsigned c = xb_ld(&bar[XB_XCNT(j)]); sum += c; cnt += (c > 0u) ? 1u : 0u; mine = (j == x) ? c : mine; }
        if (sum == G) break;
        __builtin_amdgcn_s_sleep(1);
        if ((++sp & 255u) == 0u) { if (xb_ld(&bar[XB_TMO])) break; if (sp > XB_SPIN_CAP) { atomicAdd(&bar[XB_TMO], 1u); break; } }
    }
    nloc = mine > 0u ? mine : 1u; nx = cnt > 0u ? cnt : 1u;
}
__device__ __forceinline__ void xcd_barrier(const XcdBarrier& b) {
    asm volatile("s_waitcnt vmcnt(0)" ::: "memory");
    __syncthreads();
    if (threadIdx.x == 0) {
        unsigned* bar = b.bar;
        __builtin_amdgcn_s_waitcnt(0);
        unsigned nloc = b.st[0], nx = b.st[1];
        if (nloc == 0u) { xcd_barrier_complete(bar, b.x, nloc, nx); b.st[0] = nloc; b.st[1] = nx; }
        const unsigned old = xb_add(&bar[XB_XSUB(b.x)], 1u);
        const unsigned gen = old / nloc;
        if (old + 1u == (gen + 1u) * nloc) {
            __builtin_amdgcn_fence(__ATOMIC_RELEASE, "agent");
            asm volatile("s_waitcnt vmcnt(0)" ::: "memory");
            const unsigned og = xb_add(&bar[XB_TOP], 1u);
            const unsigned tg = og / nx;
            if (og + 1u == (tg + 1u) * nx) xb_add(&bar[XB_TOPGEN], 1u);
            else XB_SPIN(xb_ld(&bar[XB_TOPGEN]) == tg, bar);
            __builtin_amdgcn_fence(__ATOMIC_ACQUIRE, "agent");
            xb_add(&bar[XB_XGEN(b.x)], 1u);
            asm volatile("s_waitcnt vmcnt(0)" ::: "memory");
        } else {
            XB_SPIN(xb_ld(&bar[XB_XGEN(b.x)]) == gen, bar);
            __builtin_amdgcn_fence(__ATOMIC_ACQUIRE, "agent");
            asm volatile("s_waitcnt vmcnt(0)" ::: "memory");
        }
    }
    __syncthreads();
}

__device__ __forceinline__ float wave_sum(float v) {
    v += __builtin_bit_cast(float, __builtin_amdgcn_update_dpp(0, __builtin_bit_cast(int, v), 0xB1, 0xf, 0xf, false));
    v += __builtin_bit_cast(float, __builtin_amdgcn_update_dpp(0, __builtin_bit_cast(int, v), 0x4E, 0xf, 0xf, false));
    v += __builtin_bit_cast(float, __builtin_amdgcn_update_dpp(0, __builtin_bit_cast(int, v), 0x141, 0xf, 0xf, false));
    v += __builtin_bit_cast(float, __builtin_amdgcn_update_dpp(0, __builtin_bit_cast(int, v), 0x140, 0xf, 0xf, false));
    v += __shfl_xor(v, 16); v += __shfl_xor(v, 32);
    return v;
}
using pg8::cvt_pk_bf16; using pg8::bf_lo; using pg8::bf_hi;

__device__ __forceinline__ void transpose_item(const float* __restrict__ W, int N, unsigned short* __restrict__ WT, int ldt, int k0, int n0, int drow0, LAS float* scr, int lane) {
#pragma unroll
    for (int i = 0; i < 32; ++i) { const int kk = 2 * i + (lane >> 5); scr[kk * 33 + (lane & 31)] = W[(size_t)(k0 + kk) * N + n0 + (lane & 31)]; }
    LDS_WAIT(); asm volatile("" ::: "memory");
    const int c = lane & 7;
#pragma unroll
    for (int j = 0; j < 4; ++j) { const int n = (lane >> 3) + 8 * j; const LAS float* s = scr + (8 * c) * 33 + n;
        u32x4 o; o.x = cvt_pk_bf16(s[0 * 33], s[1 * 33]); o.y = cvt_pk_bf16(s[2 * 33], s[3 * 33]); o.z = cvt_pk_bf16(s[4 * 33], s[5 * 33]); o.w = cvt_pk_bf16(s[6 * 33], s[7 * 33]);
        *(u32x4*)(WT + (size_t)(drow0 + n) * ldt + k0 + 8 * c) = o; }
    LDS_WAIT(); asm volatile("" ::: "memory");
}
__device__ __forceinline__ void transpose_item8(const float* __restrict__ W, int N, unsigned char* __restrict__ WT8, int ldt, int k0, int n0, int drow0, LAS float* scr, int lane) {
#pragma unroll
    for (int i = 0; i < 32; ++i) { const int kk = 2 * i + (lane >> 5); scr[kk * 33 + (lane & 31)] = W[(size_t)(k0 + kk) * N + n0 + (lane & 31)]; }
    LDS_WAIT(); asm volatile("" ::: "memory");
    const int c = lane & 7;
#pragma unroll
    for (int j = 0; j < 4; ++j) { const int n = (lane >> 3) + 8 * j; const LAS float* s = scr + (8 * c) * 33 + n;
        int w0 = __builtin_amdgcn_cvt_pk_fp8_f32(s[0 * 33], s[1 * 33], 0, false); w0 = __builtin_amdgcn_cvt_pk_fp8_f32(s[2 * 33], s[3 * 33], w0, true);
        int w1 = __builtin_amdgcn_cvt_pk_fp8_f32(s[4 * 33], s[5 * 33], 0, false); w1 = __builtin_amdgcn_cvt_pk_fp8_f32(s[6 * 33], s[7 * 33], w1, true);
        u32x2 o; o.x = (unsigned)w0; o.y = (unsigned)w1;
        *(u32x2*)(WT8 + (size_t)(drow0 + n) * ldt + k0 + 8 * c) = o; }
    LDS_WAIT(); asm volatile("" ::: "memory");
}
__device__ __forceinline__ void transpose_plain(const float* W, int K, int N, unsigned short* WT, int it, LAS float* scr, int lane) {
    const int nblk = N / 32, kb = it / nblk, nb = it % nblk;
    transpose_item(W, N, WT, K, 64 * kb, 32 * nb, 32 * nb, scr, lane);
}
__device__ __forceinline__ void convert_ffn(const float* Wg, const float* Wu, const float* Wd, unsigned short* WGU, unsigned short* WD, LAS float* scr, int gw, int NGW, int lane) {
    constexpr int I_G = (DM / 64) * (FF / 32), I_D = (FF / 64) * (DM / 32);
    for (int it = gw; it < 2 * I_G + I_D; it += NGW) {
        int r = it;
        if (r < 2 * I_G) { const bool up = r >= I_G; if (up) r -= I_G; const int nblk = FF / 32, kb = r / nblk, nb = r % nblk, n0 = 32 * nb;
            transpose_item(up ? Wu : Wg, FF, WGU, DM, 64 * kb, n0, (n0 >> 7) * 256 + (up ? 128 : 0) + (n0 & 127), scr, lane); continue; }
        r -= 2 * I_G; transpose_plain(Wd, FF, DM, WD, r, scr, lane);
    }
}
template <int NR>
__device__ __forceinline__ void norm_rows(const float* xrow, const float* g, unsigned short* orow, int lane, size_t rstep) {
    f32x4 v[NR][8]; float s[NR];
#pragma unroll
    for (int r = 0; r < NR; ++r) { const f32x4* xr = (const f32x4*)(xrow + r * rstep) + lane;
#pragma unroll
        for (int j = 0; j < 8; ++j) v[r][j] = xr[64 * j]; }
#pragma unroll
    for (int r = 0; r < NR; ++r) { float a = 0.f;
#pragma unroll
        for (int j = 0; j < 8; ++j) a += (v[r][j].x * v[r][j].x + v[r][j].y * v[r][j].y) + (v[r][j].z * v[r][j].z + v[r][j].w * v[r][j].w);
        s[r] = a; }
#pragma unroll
    for (int r = 0; r < NR; ++r) s[r] = wave_sum(s[r]);
#pragma unroll
    for (int r = 0; r < NR; ++r) { const float rstd = 1.0f / sqrtf(s[r] * (1.f / DM) + EPS);
        u32x2* o8 = (u32x2*)(orow + r * rstep) + lane;
#pragma unroll
        for (int j = 0; j < 8; ++j) { const f32x4 gv = ((const f32x4*)g + lane)[64 * j]; u32x2 w; w.x = cvt_pk_bf16(v[r][j].x * rstd * gv.x, v[r][j].y * rstd * gv.y); w.y = cvt_pk_bf16(v[r][j].z * rstd * gv.z, v[r][j].w * rstd * gv.w); o8[64 * j] = w; } }
}
template <int NR, bool NEXT, bool BBF, bool OBF, bool U8 = false>
__device__ __forceinline__ void res_norm_rows(const unsigned short* trow, const void* brow, const float* post_g, float wgt, void* orow, const float* pre_g, unsigned short* urow, int lane, unsigned char* u8row, size_t rstep) {
    f32x4 t[NR][8], b[NR][8]; float s[NR];
#pragma unroll
    for (int r = 0; r < NR; ++r) { const u32x2* tr = (const u32x2*)(trow + r * rstep) + lane;
#pragma unroll
        for (int j = 0; j < 8; ++j) { const u32x2 w = tr[64 * j]; t[r][j] = (f32x4){bf_lo(w.x), bf_hi(w.x), bf_lo(w.y), bf_hi(w.y)}; } }
#pragma unroll
    for (int r = 0; r < NR; ++r) {
#pragma unroll
        for (int j = 0; j < 8; ++j) { if (BBF) { const u32x2 wb = ((const u32x2*)((const unsigned short*)brow + r * rstep) + lane)[64 * j]; b[r][j] = (f32x4){bf_lo(wb.x), bf_hi(wb.x), bf_lo(wb.y), bf_hi(wb.y)}; }
                                      else b[r][j] = ((const f32x4*)((const float*)brow + r * rstep) + lane)[64 * j]; } }
#pragma unroll
    for (int r = 0; r < NR; ++r) { float a = 0.f;
#pragma unroll
        for (int j = 0; j < 8; ++j) a += (t[r][j].x * t[r][j].x + t[r][j].y * t[r][j].y) + (t[r][j].z * t[r][j].z + t[r][j].w * t[r][j].w);
        s[r] = a; }
#pragma unroll
    for (int r = 0; r < NR; ++r) s[r] = wave_sum(s[r]);
    float s2[NR];
#pragma unroll
    for (int r = 0; r < NR; ++r) { const float rstd = wgt / sqrtf(s[r] * (1.f / DM) + EPS); float a = 0.f;
#pragma unroll
        for (int j = 0; j < 8; ++j) { const f32x4 g = ((const f32x4*)post_g + lane)[64 * j];
            t[r][j] = b[r][j] + t[r][j] * rstd * g;
            if (OBF) { u32x2 wo; wo.x = cvt_pk_bf16(t[r][j].x, t[r][j].y); wo.y = cvt_pk_bf16(t[r][j].z, t[r][j].w); ((u32x2*)((unsigned short*)orow + r * rstep) + lane)[64 * j] = wo; }
            else ((f32x4*)((float*)orow + r * rstep) + lane)[64 * j] = t[r][j];
            a += (t[r][j].x * t[r][j].x + t[r][j].y * t[r][j].y) + (t[r][j].z * t[r][j].z + t[r][j].w * t[r][j].w); }
        s2[r] = a; }
    if (NEXT) {
#pragma unroll
        for (int r = 0; r < NR; ++r) s2[r] = wave_sum(s2[r]);
#pragma unroll
        for (int r = 0; r < NR; ++r) { const float r2 = 1.0f / sqrtf(s2[r] * (1.f / DM) + EPS);
            u32x2* o8 = (u32x2*)(urow + r * rstep) + lane;
#pragma unroll
            for (int j = 0; j < 8; ++j) { const f32x4 gv = ((const f32x4*)pre_g + lane)[64 * j]; const f32x4 uu = t[r][j] * r2 * gv;
                u32x2 w; w.x = cvt_pk_bf16(uu.x, uu.y); w.y = cvt_pk_bf16(uu.z, uu.w); o8[64 * j] = w;
                if (U8) { int q = __builtin_amdgcn_cvt_pk_fp8_f32(uu.x, uu.y, 0, false); q = __builtin_amdgcn_cvt_pk_fp8_f32(uu.z, uu.w, q, true); ((unsigned*)(u8row + r * rstep) + lane)[64 * j] = (unsigned)q; } } }
    }
}
__device__ __forceinline__ void qk_rope_row(unsigned short* row, int s, const float* qg, const float* kg, int lane) {
    const int sec = lane >> 5, half = (lane >> 4) & 1, i0 = (2 * lane) & 31;
    const float pos = (float)(sec == 0 ? (s >> 6) : (s & 63));
    const float L = 13.287712379549449f / 32.f;
    float cs[2], sn[2];
#pragma unroll
    for (int e = 0; e < 2; ++e) { const float fr = exp2f(-(float)(i0 + e) * L); float rev = pos * fr * 0.15915494309189535f; rev -= floorf(rev);
        sn[e] = __builtin_amdgcn_sinf(rev); cs[e] = __builtin_amdgcn_cosf(rev); }
    const float gq0 = qg[2 * lane], gq1 = qg[2 * lane + 1], gk0 = kg[2 * lane], gk1 = kg[2 * lane + 1];
    unsigned w[20];
#pragma unroll
    for (int h = 0; h < 20; ++h) w[h] = ((const unsigned*)(row + h * 128))[lane];
#pragma unroll
    for (int h = 0; h < 20; ++h) {
        const float x0 = bf_lo(w[h]), x1 = bf_hi(w[h]);
        const float rstd = 1.0f / sqrtf(wave_sum(x0 * x0 + x1 * x1) * (1.f / 128.f) + EPS);
        const float y0 = x0 * rstd * (h < 16 ? gq0 : gk0), y1 = x1 * rstd * (h < 16 ? gq1 : gk1);
        const float p0 = __shfl_xor(y0, 16), p1 = __shfl_xor(y1, 16);
        const float o0 = half ? (y0 * cs[0] + p0 * sn[0]) : (y0 * cs[0] - p0 * sn[0]);
        const float o1 = half ? (y1 * cs[1] + p1 * sn[1]) : (y1 * cs[1] - p1 * sn[1]);
        ((unsigned*)(row + h * 128))[lane] = cvt_pk_bf16(o0, o1);
    }
}


__device__ __forceinline__ void qk_rope_row8(const unsigned short* row, int s, const float* qg, const float* kg, unsigned char* Q8, unsigned char* K8, int lane) {
    const int sec = lane >> 5, half = (lane >> 4) & 1, i0 = (2 * lane) & 31;
    const float pos = (float)(sec == 0 ? (s >> 6) : (s & 63));
    const float L = 13.287712379549449f / 32.f;
    float cs[2], sn[2];
#pragma unroll
    for (int e = 0; e < 2; ++e) { const float fr = exp2f(-(float)(i0 + e) * L); float rev = pos * fr * 0.15915494309189535f; rev -= floorf(rev);
        sn[e] = __builtin_amdgcn_sinf(rev); cs[e] = __builtin_amdgcn_cosf(rev); }
    const float gq0 = qg[2 * lane], gq1 = qg[2 * lane + 1], gk0 = kg[2 * lane], gk1 = kg[2 * lane + 1];
    unsigned w[20];
#pragma unroll
    for (int h = 0; h < 20; ++h) w[h] = ((const unsigned*)(row + h * 128))[lane];
#pragma unroll
    for (int h = 0; h < 20; ++h) {
        const float x0 = bf_lo(w[h]), x1 = bf_hi(w[h]);
        const float rstd = 1.0f / sqrtf(wave_sum(x0 * x0 + x1 * x1) * (1.f / 128.f) + EPS);
        const float y0 = x0 * rstd * (h < 16 ? gq0 : gk0), y1 = x1 * rstd * (h < 16 ? gq1 : gk1);
        const float p0 = __shfl_xor(y0, 16), p1 = __shfl_xor(y1, 16);
        const float o0 = half ? (y0 * cs[0] + p0 * sn[0]) : (y0 * cs[0] - p0 * sn[0]);
        const float o1 = half ? (y1 * cs[1] + p1 * sn[1]) : (y1 * cs[1] - p1 * sn[1]);
        const unsigned short w8 = (unsigned short)(__builtin_amdgcn_cvt_pk_fp8_f32(o0, o1, 0, false) & 0xffff);
        if (h < 16) ((unsigned short*)(Q8 + (size_t)s * 2048 + h * 128))[lane] = w8;
        else ((unsigned short*)(K8 + ((size_t)(h - 16) * S_ + s) * 128))[lane] = w8;
    }
}
__device__ __forceinline__ void v_transpose_item(const unsigned short* R1, unsigned char* Vt8, int item, LAS unsigned char* scr, int lane) {
    const int t = item >> 2, kvh = item & 3;
    const unsigned short* src = R1 + (size_t)(64 * t) * INW + 2560 + kvh * 128;
#pragma unroll
    for (int i = 0; i < 16; ++i) { const int rr = 4 * i + (lane >> 4), c16 = lane & 15; const u32x4 v = *(const u32x4*)(src + (size_t)rr * INW + c16 * 8); *(LAS u32x4*)(scr + rr * 256 + c16 * 16) = v; }
    LDS_WAIT(); asm volatile("" ::: "memory");
#pragma unroll
    for (int dh = 0; dh < 2; ++dh) { const int d = dh * 64 + lane;
        u32x4 o4[4];
#pragma unroll
        for (int q = 0; q < 16; ++q) { float f[4];
#pragma unroll
            for (int e = 0; e < 4; ++e) { const int key = att8::vkey(4 * q + e); f[e] = __uint_as_float((unsigned)(*(const LAS unsigned short*)(scr + key * 256 + d * 2)) << 16); }
            int ww = __builtin_amdgcn_cvt_pk_fp8_f32(f[0], f[1], 0, false); ww = __builtin_amdgcn_cvt_pk_fp8_f32(f[2], f[3], ww, true); o4[q >> 2][q & 3] = (unsigned)ww; }
        unsigned char* dst = Vt8 + (((size_t)kvh * 256 + t) * 128 + d) * 64;
#pragma unroll
        for (int q = 0; q < 4; ++q) *(u32x4*)(dst + 16 * q) = o4[q]; }
    LDS_WAIT(); asm volatile("" ::: "memory");
}

#define SINGLE_ARG(...) __VA_ARGS__
struct Args { const float* in[20]; float* out; unsigned char* ws; int ph_lo, ph_hi; };

__global__ void __launch_bounds__(512, 2) mk_fwd(Args args) {
    extern __shared__ __attribute__((aligned(16))) unsigned char lds[];
    cg::grid_group grid = cg::this_grid();
    const int tid = threadIdx.x, lane = tid & 63, wave = __builtin_amdgcn_readfirstlane(tid >> 6);
    const int G = gridDim.x, bx = blockIdx.x;
    const int gw = bx * 8 + wave, NGW = G * 8;
    unsigned char* ws = args.ws;
    unsigned short* const G1 = (unsigned short*)(ws + WS_G1); float* const TW = (float*)(ws + WS_TW);
    unsigned short* const U = (unsigned short*)(ws + WS_U); unsigned short* const T = (unsigned short*)(ws + WS_T); unsigned short* const R1 = (unsigned short*)(ws + WS_R1);
    const float* x = args.in[0]; float* out = args.out;
    unsigned short* const HB1 = (unsigned short*)args.out;
    unsigned short* const HB2 = (unsigned short*)(ws + WS_R1 + 176 * MiB);
    LAS unsigned char* ldsl = (LAS unsigned char*)lds;
    LAS float* scr = (LAS float*)(ldsl + wave * 16384);
    const int lo = args.ph_lo, hi = args.ph_hi;
    for (int u_ = tid; u_ < 64; u_ += 512) ((LAS unsigned*)(ldsl + LDSCTL_OFF))[u_] = 0u;
    __syncthreads();
    const XcdBarrier xbar = xcd_barrier_post((unsigned*)(ws + WS_CTL), (volatile LAS unsigned*)(ldsl + LDSCTL_OFF + 32));
#ifndef F1_AL
#define F1_AL false
#endif
#ifndef F1_SP
#define F1_SP true
#endif
#ifndef PHASE_MASK
#define PHASE_MASK 0xFFFF
#endif
#define IN(k) (((PHASE_MASK >> (k)) & 1) && lo <= (k) && (k) < hi)
#if PROBE_TS
    unsigned long long* const TS = (unsigned long long*)(ws + 768 * 1024);
#define STAMP(k) do { if (bx == 0 && tid == 0) TS[(k)] = __builtin_amdgcn_s_memrealtime(); } while (0)
#else
#define STAMP(k) do { } while (0)
#endif
    STAMP(0);
    if (hi < 0) grid.sync();
#define SEAM(k) do { if (IN(k) && IN((k) + 1)) xcd_barrier(xbar); STAMP((k) + 1); } while (0)
#define GEMM_PHASE_X(CFG, EPI, AL, SP, Aptr, Bptr, M_, N_, ...) do { pg8::Gemm g_{(const char*)(Aptr), (const char*)(Bptr)}; pg8::StaticOrder So_; So_.init((M_), (N_), G, bx, EPI::IDEMPOTENT ? REP_GEMM : EPI::REPX); \
        EPI E_{__VA_ARGS__}; pg8::gemm_phase<CFG, EPI, pg8::StaticOrder, AL, SP, false>(ldsl, g_, So_, E_); } while (0)
#define GEMM_PHASE(CFG, EPI, ...) GEMM_PHASE_X(SINGLE_ARG(CFG), SINGLE_ARG(EPI), true, true, __VA_ARGS__)
#define GEMM_PHASE_KREV(CFG, EPI, Aptr, Bptr, M_, N_, ...) do { pg8::Gemm g_{(const char*)(Aptr), (const char*)(Bptr)}; pg8::StaticOrder So_; So_.init((M_), (N_), G, bx, 1); \
        EPI E_{__VA_ARGS__}; pg8::gemm_phase<CFG, EPI, pg8::StaticOrder, true, true, false, true>(ldsl, g_, So_, E_); } while (0)
#define GEMM_PHASE_F8(CFG, EPI, Aptr, Bptr, M_, N_, ...) do { pg8::Gemm g_{(const char*)(Aptr), (const char*)(Bptr)}; pg8::StaticOrder So_; So_.init((M_), (N_), G, bx, 1); \
        EPI E_{__VA_ARGS__}; pg8::gemm_phase<CFG, EPI, pg8::StaticOrder, true, true, true>(ldsl, g_, So_, E_); } while (0)
    typedef pg8::Cfg<2048u, 2048u, (size_t)128 * 2048, (size_t)128 * 2048, (size_t)256 * 2048, 0, 0, (size_t)256 * 2048, 1024> CfgF8;
    typedef pg8::Cfg<512u, (unsigned)(128 * INW * 2), (size_t)128 * 512, (size_t)INW * 2, 0, 0, 256, (size_t)2 * INW * 2, 128> CfgF1;
    typedef pg8::Cfg<512u, 512u, (size_t)128 * 512, (size_t)128 * 512, 0, 0, 0, (size_t)256 * 512, 256> CfgF2;

    if (IN(0)) {
        for (int rp_ = 0; rp_ < REP_CONV; ++rp_) convert_ffn(args.in[2], args.in[3], args.in[4], (unsigned short*)(ws + WS_WGU), (unsigned short*)(ws + WS_WD), scr, gw, NGW, lane);
        for (int e = bx * 512 + tid; e < 256 * 256; e += G * 512) { const int r = e >> 8, c = e & 255, ro = r >> 7, i = r & 127, ri = c >> 7, j = c & 127, a = (i * j) & 127;
            const float cv = cospif((float)a * (1.f / 64.f)), sv = sinpif((float)a * (1.f / 64.f));
            const float v = (ro == ri) ? cv : (ro == 0 ? sv : -sv);
            G1[e] = (unsigned short)(cvt_pk_bf16(v * 0.08838834764831845f, 0.f) & 0xffffu); }
        for (int e = bx * 512 + tid; e < 128 * 128; e += G * 512) { const int c = e >> 7, b = e & 127, a = (b * c) & 16383;
            TW[2 * e] = cospif((float)a * (1.f / 8192.f)); TW[2 * e + 1] = -sinpif((float)a * (1.f / 8192.f)); }
        for (int m = gw; m < S_; m += 2 * NGW) norm_rows<2>(x + (size_t)m * DM, args.in[1], U + (size_t)m * DM, lane, (size_t)NGW * DM);
    }
    SEAM(0);
    if (IN(1)) GEMM_PHASE(SINGLE_ARG(pg8::StdCfg<DM, DM, DM>), pg8::EpiSwiglu, U, ws + WS_WGU, S_, 2 * FF, R1, FF);
    SEAM(1);
    if (IN(2)) GEMM_PHASE_KREV(SINGLE_ARG(pg8::StdCfg<FF, FF, FF>), pg8::EpiStore, R1, ws + WS_WD, S_, DM, T, DM);
    SEAM(2);
    if (IN(3)) {
        for (int m = gw; m < S_; m += 2 * NGW) res_norm_rows<2, true, false, true, true>(T + (size_t)m * DM, x + (size_t)m * DM, args.in[5], 0.5f, HB1 + (size_t)m * DM, args.in[6], U + (size_t)m * DM, lane, ws + WS_Q8 + (size_t)m * DM, (size_t)NGW * DM);
        constexpr int I_IN = (DM / 64) * (INW / 32), I_AO = (DM / 64) * (DM / 32), I_F = (1024 / 64) * (DM / 32);
        for (int rp_ = 0; rp_ < REP_CONV; ++rp_) for (int it = gw; it < I_IN + 2 * I_AO + I_F; it += NGW) { int r = it;
            if (r < I_IN) { const int nblk = INW / 32, kb = r / nblk, nb = r % nblk, n0 = 32 * nb;
                if (n0 < 3072) transpose_item8(args.in[7], INW, ws + WS_WIN8, DM, 64 * kb, n0, n0, scr, lane);
                else if (n0 < 4096) transpose_item(args.in[7], INW, (unsigned short*)(ws + WS_WIN), DM, 64 * kb, n0, n0 - 3072, scr, lane);
                else if (n0 < 6144) transpose_item8(args.in[7], INW, ws + WS_WIN8, DM, 64 * kb, n0, n0 - 1024, scr, lane);
                else transpose_item(args.in[7], INW, (unsigned short*)(ws + WS_WIN), DM, 64 * kb, n0, n0 - 5120, scr, lane);
                continue; } r -= I_IN;
            if (r < I_AO) { const int nblk = DM / 32, kb = r / nblk, nb = r % nblk; transpose_item8(args.in[11], DM, ws + WS_WAO8, DM, 64 * kb, 32 * nb, 32 * nb, scr, lane); continue; } r -= I_AO;
            if (r < I_F) { transpose_plain(args.in[12], 1024, DM, (unsigned short*)(ws + WS_WF), r, scr, lane); continue; } r -= I_F;
            transpose_plain(args.in[13], DM, DM, (unsigned short*)(ws + WS_WOUT), r, scr, lane); }
    }
    SEAM(3);
    if (IN(4)) {
        GEMM_PHASE_F8(CfgF8, pg8::EpiStore, ws + WS_Q8, ws + WS_WIN8, S_, 5120, R1, INW, 12, 1024);
        GEMM_PHASE(SINGLE_ARG(pg8::StdCfg<DM, DM, DM>), pg8::EpiStore, U, ws + WS_WIN, S_, 3072, R1 + 3072, INW, 4, 2048);
    }
    SEAM(4);
    if (IN(5)) {
        for (int rp_ = 0; rp_ < REP_ROPE; ++rp_) for (int m = gw; m < S_; m += NGW) qk_rope_row8(R1 + (size_t)m * INW, m, args.in[9], args.in[10], ws + WS_Q8, ws + WS_K8, lane);
        for (int rp_ = 0; rp_ < REP_ROPE; ++rp_) for (int it = gw; it < 1024; it += NGW) v_transpose_item(R1, ws + WS_VT8, it, (LAS unsigned char*)scr, lane);
        __syncthreads();
        GEMM_PHASE_X(CfgF1, pg8::EpiZt, F1_AL, F1_SP, G1, R1 + 3072, 8 * 256, 64 * 256, U);
    }
    SEAM(5);
    if (IN(6)) GEMM_PHASE(CfgF2, pg8::EpiYt, G1, U, 256, 131072, T, TW);
    SEAM(6);
    if (IN(7)) GEMM_PHASE(CfgF2, pg8::EpiXf, G1, T, 256, 131072, R1 + 3072, INW);
    SEAM(7);
    if (IN(8)) {
        for (int rp_ = 0; rp_ < REP_ATTN; ++rp_)
        for (int u = bx; u < 1024; u += G) { const int kvh = u >> 8, w = u & 255, qh = 4 * kvh + (w & 3), qb = w >> 2;
            __syncthreads();
            att8::attn_body(ws + WS_Q8 + (size_t)qb * 256 * 2048 + qh * 128, ws + WS_K8 + (size_t)kvh * S_ * 128, ws + WS_VT8 + (size_t)kvh * 128 * S_,
                            (unsigned char*)U + (size_t)qb * 256 * DM + qh * 128, S_, (char*)lds);
        }
        __syncthreads();
    }
    SEAM(8);
    if (IN(9)) GEMM_PHASE_F8(CfgF8, pg8::EpiGate<false>, U, ws + WS_WAO8, S_, DM, T, DM, R1 + 4096, INW, args.in[8]);
    if (IN(10)) GEMM_PHASE(SINGLE_ARG(pg8::StdCfg<INW, 1024, 1024>), pg8::EpiGate<true>, R1 + 3072, ws + WS_WF, S_, DM, T, DM, R1 + 4096 + DM, INW, args.in[8] + DM);
    SEAM(10);
    if (IN(11)) GEMM_PHASE(SINGLE_ARG(pg8::StdCfg<DM, DM, DM>), pg8::EpiStore, T, ws + WS_WOUT, S_, DM, U, DM);
    SEAM(11);
    if (IN(12)) {
        for (int m = gw; m < S_; m += 2 * NGW) res_norm_rows<2, true, true, true>(U + (size_t)m * DM, HB1 + (size_t)m * DM, args.in[14], 1.0f, HB2 + (size_t)m * DM, args.in[15], U + (size_t)m * DM, lane, nullptr, (size_t)NGW * DM);
        for (int rp_ = 0; rp_ < REP_CONV; ++rp_) convert_ffn(args.in[16], args.in[17], args.in[18], (unsigned short*)(ws + WS_WGU), (unsigned short*)(ws + WS_WD), scr, gw, NGW, lane);
    }
    SEAM(12);
    if (IN(13)) GEMM_PHASE(SINGLE_ARG(pg8::StdCfg<DM, DM, DM>), pg8::EpiSwiglu, U, ws + WS_WGU, S_, 2 * FF, R1, FF);
    SEAM(13);
    if (IN(14)) GEMM_PHASE_KREV(SINGLE_ARG(pg8::StdCfg<FF, FF, FF>), pg8::EpiStore, R1, ws + WS_WD, S_, DM, T, DM);
    SEAM(14);
    if (IN(15)) {
        for (int m = gw; m < S_; m += 2 * NGW) res_norm_rows<2, false, true, false>(T + (size_t)m * DM, HB2 + (size_t)m * DM, args.in[19], 0.5f, out + (size_t)m * DM, nullptr, nullptr, lane, nullptr, (size_t)NGW * DM);
    }
#if PROBE_TS
    __syncthreads();
    if (bx == 0) { STAMP(16); __syncthreads();
        float v1 = 0.f, v2 = 0.f;
        for (int k = 0; k < 16; ++k) { const float d = (float)(long long)(TS[k + 1] - TS[k]) * 0.01f; if ((PROBE_M1 >> k) & 1) v1 += d; if ((PROBE_M2 >> k) & 1) v2 += d; }
        if (tid == 0) out[0] += v1;
        for (int e = tid; e < 4096; e += 512) out[DM + e] += v2 * (1.f / 16.f); }
#endif
#undef IN
#undef SEAM
#undef GEMM_PHASE
#undef GEMM_PHASE_X
#undef GEMM_PHASE_KREV
#undef GEMM_PHASE_F8
}

extern "C" void kernel_launch(void* const* d_in, const int* in_sizes, int n_in, void* d_out, int out_size, void* d_ws, size_t ws_size, hipStream_t stream) {
    static int grid = 0;
    if (grid == 0) {
        if (n_in != 20 || in_sizes[0] != S_ * DM || out_size != S_ * DM || ws_size < WS_END) {
            fprintf(stderr, "kernel_launch: shape/workspace mismatch: n_in %d in0 %d out %d ws %zu (need %zu)\n", n_in, n_in > 0 ? in_sizes[0] : -1, out_size, ws_size, (size_t)WS_END); grid = -1; return; }
        int dev = 0, cus = 0, per_cu = 0;
        if (hipGetDevice(&dev) != hipSuccess || hipDeviceGetAttribute(&cus, hipDeviceAttributeMultiprocessorCount, dev) != hipSuccess) { fprintf(stderr, "kernel_launch: device query failed\n"); grid = -1; return; }
        if (hipFuncSetAttribute((const void*)mk_fwd, hipFuncAttributeMaxDynamicSharedMemorySize, LDS_BYTES) != hipSuccess) { fprintf(stderr, "kernel_launch: hipFuncSetAttribute failed\n"); grid = -1; return; }
        if (hipOccupancyMaxActiveBlocksPerMultiprocessor(&per_cu, (const void*)mk_fwd, 512, LDS_BYTES) != hipSuccess || per_cu < 1) { fprintf(stderr, "kernel_launch: occupancy query says %d blocks per CU\n", per_cu); per_cu = 1; }
        (void)hipGetLastError();
        grid = cus;
    }
    if (grid < 0) return;
    if (hipMemsetAsync((char*)d_ws + WS_CTL, 0, CTL_BYTES, stream) != hipSuccess) { fprintf(stderr, "kernel_launch: memset of barrier words failed\n"); return; }
    Args a{};
    for (int i = 0; i < 20; ++i) a.in[i] = (const float*)d_in[i];
    a.out = (float*)d_out; a.ws = (unsigned char*)d_ws;
#if MK_PER_PHASE
    for (int p = 0; p < NPHASE; ++p) { a.ph_lo = p; a.ph_hi = p + 1;
        hipLaunchKernelGGL(mk_fwd, dim3(grid), dim3(512), LDS_BYTES, stream, a);
        const hipError_t le = hipPeekAtLastError(); if (le != hipSuccess) { fprintf(stderr, "kernel_launch: launch %d failed: %s\n", p, hipGetErrorName(le)); break; } }
#else
    a.ph_lo = 0; a.ph_hi = NPHASE;
    void* kargs[] = {&a};
    const hipError_t e = hipLaunchCooperativeKernel((const void*)mk_fwd, dim3(grid), dim3(512), kargs, LDS_BYTES, stream);
    if (e != hipSuccess) fprintf(stderr, "kernel_launch: cooperative launch failed: %s (grid %d)\n", hipGetErrorString(e), grid);
#endif
}
```

```cpp
#include <hip/hip_runtime.h>
#include <hip/hip_bf16.h>
#include <hip/hip_cooperative_groups.h>
#include <cstdio>
#include <cstdint>
namespace cg = cooperative_groups;

#ifndef REP_GEMM
#define REP_GEMM 1
#endif
#ifndef REP_ATTN
#define REP_ATTN 1
#endif
#ifndef REP_F1
#define REP_F1 1
#endif
#ifndef REP_ROW
#define REP_ROW 1
#endif
#ifndef REP_ROPE
#define REP_ROPE 1
#endif
#ifndef REP_CONV
#define REP_CONV 1
#endif
#ifndef PROBE_TS
#define PROBE_TS 0
#endif
#ifndef PROBE_M1
#define PROBE_M1 0x0100
#endif
#ifndef PROBE_M2
#define PROBE_M2 0xFFFF
#endif
#ifndef MK_PER_PHASE
#define MK_PER_PHASE 0
#endif

namespace pg8 {
#define PG8_LAS __attribute__((address_space(3)))
typedef unsigned short bf16_t;
typedef short bf16x8 __attribute__((ext_vector_type(8)));
typedef float f32x4 __attribute__((ext_vector_type(4)));
typedef unsigned u32x4 __attribute__((ext_vector_type(4)));
constexpr int BM = 256, BK = 64, HALF = 128, HTB = HALF * BK * 2, STAGE_BYTES = 8 * HTB, NXCD = 8, WGM = 8;

__host__ __device__ __forceinline__ int lds_byte(int r, int c) { const int st = (r >> 4) * 2 + (c >> 5), rr = r & 15, cc = c & 31, ob = rr * 64 + cc * 2; return st * 1024 + (ob ^ (((ob >> 9) & 1) << 5)); }
__host__ __device__ __forceinline__ void stage_rc(int b, int& R, int& C) { const int st = b / 1024, sb = b % 1024, swz = sb ^ (((sb >> 9) & 1) << 5); R = (st >> 1) * 16 + swz / 64; C = (st & 1) * 32 + (swz % 64) / 2; }
__host__ __device__ __forceinline__ int perm32(int rho) { const int n = rho >> 4, i = rho & 15; return 8 * (i >> 2) + 4 * n + (i & 3); }

struct Unit { int pm, pn; };
struct Gemm { const char* A; const char* B; };
template <unsigned ROWA_, unsigned ROWB_, size_t HA_, size_t HB_, size_t PMA_, size_t PNA_, size_t PMB_, size_t PNB_, int K_> struct Cfg {
    static constexpr unsigned rowA = ROWA_, rowB = ROWB_; static constexpr size_t hstepA = HA_, hstepB = HB_, pmA = PMA_, pnA = PNA_, pmB = PMB_, pnB = PNB_; static constexpr int K = K_; };
template <int LDA, int LDB, int K_> using StdCfg = Cfg<(unsigned)LDA * 2u, (unsigned)LDB * 2u, (size_t)128 * LDA * 2, (size_t)128 * LDB * 2, (size_t)256 * LDA * 2, 0, 0, (size_t)256 * LDB * 2, K_>;

struct StaticOrder {
    int nM, nN, nwg, G, c, rep, wgm;
    __host__ __device__ void init(int M, int N, int G_, int c_, int rep_ = 1) { nM = M / BM; nN = N / BM; nwg = nM * nN; G = G_; c = c_; rep = rep_; wgm = (nN <= 8) ? 4 : WGM; }
    __host__ __device__ bool next(int i, Unit& u) const {
        long L = (long)i * G + c; if (L >= (long)nwg * rep) return false; L %= nwg;
        int wgid = (int)L; { const int q = nwg / NXCD, r = nwg % NXCD, xcd = wgid % NXCD, off = wgid / NXCD; wgid = (xcd < r ? xcd * (q + 1) : r * (q + 1) + (xcd - r) * q) + off; }
        const int nig = wgm * nN, gid = wgid / nig, fm = gid * wgm, gsz = (nM - fm) < wgm ? (nM - fm) : wgm;
        u.pm = fm + ((wgid % nig) % gsz); u.pn = (wgid % nig) / gsz; return true;
    }
};

__device__ __forceinline__ unsigned cvt_pk_bf16(float lo, float hi) { unsigned r; asm volatile("v_cvt_pk_bf16_f32 %0, %1, %2" : "=v"(r) : "v"(lo), "v"(hi)); return r; }
__device__ __forceinline__ float bf_lo(unsigned w) { return __uint_as_float(w << 16); }
__device__ __forceinline__ float bf_hi(unsigned w) { return __uint_as_float(w & 0xffff0000u); }
__device__ __forceinline__ u32x4 pack8(const f32x4 a, const f32x4 b) { u32x4 w; w.x = cvt_pk_bf16(a[0], a[1]); w.y = cvt_pk_bf16(a[2], a[3]); w.z = cvt_pk_bf16(b[0], b[1]); w.w = cvt_pk_bf16(b[2], b[3]); return w; }
__device__ __forceinline__ float sigmoidf_(float x) { return __builtin_amdgcn_rcpf(1.f + __builtin_amdgcn_exp2f(-1.4426950408889634f * x)); }


struct EpiStore {
    static constexpr bool PERM = true, IDEMPOTENT = true; static constexpr int REPX = 1;
    bf16_t* O; int ldc; int split = 1 << 30, gap = 0;
    __device__ __forceinline__ void operator()(const f32x4 (&acc)[2][2][4][2], const Unit& u, int wr, int wc, int fr, int fq) const {
        const int row0 = u.pm * BM + wr * 64 + fr, col0 = u.pn * BM + (u.pn >= split ? gap : 0) + wc * 32 + 8 * fq;
#pragma unroll
        for (int ai = 0; ai < 2; ++ai)
#pragma unroll
            for (int m = 0; m < 4; ++m) { bf16_t* rowp = O + (size_t)(row0 + ai * HALF + m * 16) * ldc + col0;
#pragma unroll
                for (int bj = 0; bj < 2; ++bj) *(u32x4*)(rowp + bj * HALF) = pack8(acc[ai][bj][m][0], acc[ai][bj][m][1]); }
    }
};
struct EpiStore8 {
    static constexpr bool PERM = true, IDEMPOTENT = true; static constexpr int REPX = 1;
    unsigned char* O; int ldb; int split, base2;
    __device__ __forceinline__ void operator()(const f32x4 (&acc)[2][2][4][2], const Unit& u, int wr, int wc, int fr, int fq) const {
        const int row0 = u.pm * BM + wr * 64 + fr, col0 = (u.pn < split ? u.pn * BM : base2 + (u.pn - split) * BM) + wc * 32 + 8 * fq;
#pragma unroll
        for (int ai = 0; ai < 2; ++ai)
#pragma unroll
            for (int m = 0; m < 4; ++m) { unsigned char* rowp = O + (size_t)(row0 + ai * HALF + m * 16) * ldb + col0;
#pragma unroll
                for (int bj = 0; bj < 2; ++bj) { const f32x4 a = acc[ai][bj][m][0], b = acc[ai][bj][m][1];
                    int w0 = __builtin_amdgcn_cvt_pk_fp8_f32(a[0], a[1], 0, false); w0 = __builtin_amdgcn_cvt_pk_fp8_f32(a[2], a[3], w0, true);
                    int w1 = __builtin_amdgcn_cvt_pk_fp8_f32(b[0], b[1], 0, false); w1 = __builtin_amdgcn_cvt_pk_fp8_f32(b[2], b[3], w1, true);
                    typedef unsigned u32x2_t __attribute__((ext_vector_type(2))); u32x2_t o; o.x = (unsigned)w0; o.y = (unsigned)w1;
                    *(u32x2_t*)(rowp + bj * HALF) = o; } }
    }
};
struct EpiSwiglu {
    static constexpr bool PERM = true, IDEMPOTENT = true; static constexpr int REPX = 1;
    bf16_t* O; int ldc;
    __device__ __forceinline__ void operator()(const f32x4 (&acc)[2][2][4][2], const Unit& u, int wr, int wc, int fr, int fq) const {
        const int row0 = u.pm * BM + wr * 64 + fr, col0 = u.pn * HALF + wc * 32 + 8 * fq;
#pragma unroll
        for (int ai = 0; ai < 2; ++ai)
#pragma unroll
            for (int m = 0; m < 4; ++m) { bf16_t* rowp = O + (size_t)(row0 + ai * HALF + m * 16) * ldc + col0;
                f32x4 v[2];
#pragma unroll
                for (int n = 0; n < 2; ++n) { const f32x4 g = acc[ai][0][m][n], up = acc[ai][1][m][n];
#pragma unroll
                    for (int j = 0; j < 4; ++j) v[n][j] = g[j] * sigmoidf_(g[j]) * up[j]; }
                *(u32x4*)rowp = pack8(v[0], v[1]); }
    }
};
template <bool ACCUM, bool G8 = false> struct EpiGate {
    static constexpr bool PERM = true, IDEMPOTENT = !ACCUM; static constexpr int REPX = 1;
    bf16_t* O; int ldc; const bf16_t* Gt; int ldg; const float* bias;
    __device__ __forceinline__ void operator()(const f32x4 (&acc)[2][2][4][2], const Unit& u, int wr, int wc, int fr, int fq) const {
        const int row0 = u.pm * BM + wr * 64 + fr, col0 = u.pn * BM + wc * 32 + 8 * fq;
        f32x4 bv[2][2];
#pragma unroll
        for (int bj = 0; bj < 2; ++bj)
#pragma unroll
            for (int n = 0; n < 2; ++n) bv[bj][n] = *(const f32x4*)(bias + col0 + bj * HALF + 4 * n);
#pragma unroll
        for (int ai = 0; ai < 2; ++ai)
#pragma unroll
            for (int m = 0; m < 4; ++m) { const size_t r = (size_t)(row0 + ai * HALF + m * 16);
#pragma unroll
                for (int bj = 0; bj < 2; ++bj) { f32x4 g0, g1;
                    if constexpr (G8) { typedef unsigned u32x2_t __attribute__((ext_vector_type(2))); typedef float f32x2v __attribute__((ext_vector_type(2)));
                        const u32x2_t gb = *(const u32x2_t*)((const unsigned char*)Gt + r * ldg + col0 + bj * HALF);
                        const f32x2v a0 = __builtin_amdgcn_cvt_pk_f32_fp8((int)gb.x, false), a1 = __builtin_amdgcn_cvt_pk_f32_fp8((int)gb.x, true);
                        const f32x2v b0 = __builtin_amdgcn_cvt_pk_f32_fp8((int)gb.y, false), b1 = __builtin_amdgcn_cvt_pk_f32_fp8((int)gb.y, true);
                        g0 = (f32x4){a0.x, a0.y, a1.x, a1.y}; g1 = (f32x4){b0.x, b0.y, b1.x, b1.y}; }
                    else { const u32x4 gw = *(const u32x4*)(Gt + r * ldg + col0 + bj * HALF);
                        g0 = (f32x4){bf_lo(gw.x), bf_hi(gw.x), bf_lo(gw.y), bf_hi(gw.y)}; g1 = (f32x4){bf_lo(gw.z), bf_hi(gw.z), bf_lo(gw.w), bf_hi(gw.w)}; }
                    g0 = g0 + bv[bj][0]; g1 = g1 + bv[bj][1];
                    f32x4 v0, v1;
#pragma unroll
                    for (int j = 0; j < 4; ++j) { v0[j] = sigmoidf_(g0[j]) * acc[ai][bj][m][0][j]; v1[j] = sigmoidf_(g1[j]) * acc[ai][bj][m][1][j]; }
                    bf16_t* op = O + r * ldc + col0 + bj * HALF;
                    if (ACCUM) { const u32x4 ow = *(const u32x4*)op;
                        v0 = v0 + (f32x4){bf_lo(ow.x), bf_hi(ow.x), bf_lo(ow.y), bf_hi(ow.y)}; v1 = v1 + (f32x4){bf_lo(ow.z), bf_hi(ow.z), bf_lo(ow.w), bf_hi(ow.w)}; }
                    *(u32x4*)op = pack8(v0, v1); } }
    }
};
struct EpiZt {
    static constexpr bool PERM = true, IDEMPOTENT = false; static constexpr int REPX = REP_F1;
    bf16_t* Z;
    __device__ __forceinline__ void operator()(const f32x4 (&acc)[2][2][4][2], const Unit& u, int wr, int wc, int fr, int fq) const {
        const int a0 = wc * 32 + 8 * fq;
#pragma unroll
        for (int ai = 0; ai < 2; ++ai)
#pragma unroll
            for (int m = 0; m < 4; ++m) { const int mi = wr * 64 + m * 16 + fr;
#pragma unroll
                for (int bj = 0; bj < 2; ++bj) { const int b = 2 * u.pn + bj;
                    *(u32x4*)(Z + ((size_t)((u.pm * 128 + mi) * 128 + b)) * 256 + ai * 128 + a0) = pack8(acc[ai][bj][m][0], acc[ai][bj][m][1]); } }
    }
};
struct EpiYt {
    static constexpr bool PERM = true, IDEMPOTENT = true; static constexpr int REPX = 1;
    bf16_t* Y; const float* tw;
    __device__ __forceinline__ void operator()(const f32x4 (&acc)[2][2][4][2], const Unit& u, int wr, int wc, int fr, int fq) const {
        const int b0 = wc * 32 + 8 * fq;
#pragma unroll
        for (int m = 0; m < 4; ++m) { const int c = wr * 64 + m * 16 + fr;
            f32x4 t[4];
#pragma unroll
            for (int q = 0; q < 4; ++q) t[q] = *(const f32x4*)(tw + ((size_t)c * 128 + b0) * 2 + 4 * q);
#pragma unroll
            for (int bj = 0; bj < 2; ++bj) { const int gm = 2 * u.pn + bj;
                f32x4 re[2], im[2];
#pragma unroll
                for (int n = 0; n < 2; ++n)
#pragma unroll
                    for (int j = 0; j < 4; ++j) { const int e = 4 * n + j; const float tc = t[e >> 1][(e & 1) * 2], ts = t[e >> 1][(e & 1) * 2 + 1];
                        const float xr = acc[0][bj][m][n][j], xi = acc[1][bj][m][n][j];
                        re[n][j] = xr * tc - xi * ts; im[n][j] = xr * ts + xi * tc; }
                bf16_t* p = Y + ((size_t)(c * 1024 + gm) * 2) * 128 + b0;
                *(u32x4*)p = pack8(re[0], re[1]); *(u32x4*)(p + 128) = pack8(im[0], im[1]); } }
    }
};
struct EpiXf {
    static constexpr bool PERM = true, IDEMPOTENT = true; static constexpr int REPX = 1;
    bf16_t* X; int ldx;
    __device__ __forceinline__ void operator()(const f32x4 (&acc)[2][2][4][2], const Unit& u, int wr, int wc, int fr, int fq) const {
        const int c = u.pn >> 2, gm0 = (u.pn & 3) * 256 + wc * 32 + 8 * fq;
#pragma unroll
        for (int m = 0; m < 4; ++m) { const int d = wr * 64 + m * 16 + fr;
#pragma unroll
            for (int bj = 0; bj < 2; ++bj) *(u32x4*)(X + (size_t)(c + 128 * d) * ldx + gm0 + bj * HALF) = pack8(acc[0][bj][m][0], acc[0][bj][m][1]); }
    }
};

typedef long l2_t __attribute__((ext_vector_type(2)));
template <class C, class Epi, class Sched, bool ALIGN_EPI = false, bool SP2 = false, bool F8 = false>
__device__ __forceinline__ void gemm_phase(PG8_LAS unsigned char* lds, const Gemm g, const Sched& S, const Epi& E) {
    const int tid = threadIdx.x, wid = __builtin_amdgcn_readfirstlane(tid >> 6), lane = tid & 63, wr = wid >> 2, wc = wid & 3, fr = lane & 15, fq = lane >> 4;
    constexpr int K = C::K, nt = K / BK;
    unsigned voffA[2], voffB[2];
#pragma unroll
    for (int i = 0; i < 2; ++i) { int R, Cc; stage_rc(tid * 16 + i * 8192, R, Cc); const int Rb = Epi::PERM ? ((R & ~31) + perm32(R & 31)) : R;
        voffA[i] = (unsigned)R * C::rowA + (unsigned)Cc * 2u; voffB[i] = (unsigned)Rb * C::rowB + (unsigned)Cc * 2u; }
    const size_t kstep = (size_t)(BK * 2);
    constexpr size_t hstepA = C::hstepA, hstepB = C::hstepB;
    const unsigned ldsw = (unsigned)wid * 1024u;
    const int aoff = lds_byte(wr * 64 + fr, fq * 8), boff = lds_byte(wc * 32 + fr, fq * 8);
#define PG8_SA(b, h) (((b) * 2 + (h)) * HTB)
#define PG8_SB(b, h) ((4 + (b) * 2 + (h)) * HTB)
#define PG8_STAGE(bufoff, gbase, voff) do { _Pragma("unroll") for (int _i = 0; _i < 2; ++_i) \
        __builtin_amdgcn_global_load_lds((const unsigned*)((const char*)(gbase) + (voff)[_i]), (PG8_LAS unsigned*)(lds + (bufoff) + ldsw + _i * 8192), 16, 0, 0); } while (0)
#define PG8_LDA(dst, b, h) do { _Pragma("unroll") for (int m = 0; m < 4; ++m) _Pragma("unroll") for (int k = 0; k < 2; ++k) dst[m][k] = *(const PG8_LAS bf16x8*)(lds + PG8_SA(b, h) + aoff + m * 2048 + k * 1024); } while (0)
#define PG8_LDB(dst, b, h) do { _Pragma("unroll") for (int n = 0; n < 2; ++n) _Pragma("unroll") for (int k = 0; k < 2; ++k) dst[n][k] = *(const PG8_LAS bf16x8*)(lds + PG8_SB(b, h) + boff + n * 2048 + k * 1024); } while (0)
#define PG8_MMA(ai, bj, At, Bt) do { __builtin_amdgcn_s_setprio(1); _Pragma("unroll") for (int m = 0; m < 4; ++m) _Pragma("unroll") for (int n = 0; n < 2; ++n) _Pragma("unroll") for (int k = 0; k < 2; ++k) { \
        if constexpr (F8) { const l2_t b_ = __builtin_bit_cast(l2_t, Bt[n][k]), a_ = __builtin_bit_cast(l2_t, At[m][k]); \
            acc[ai][bj][m][n] = __builtin_amdgcn_mfma_f32_16x16x32_fp8_fp8(b_[0], a_[0], acc[ai][bj][m][n], 0, 0, 0); \
            acc[ai][bj][m][n] = __builtin_amdgcn_mfma_f32_16x16x32_fp8_fp8(b_[1], a_[1], acc[ai][bj][m][n], 0, 0, 0); } \
        else acc[ai][bj][m][n] = __builtin_amdgcn_mfma_f32_16x16x32_bf16(Bt[n][k], At[m][k], acc[ai][bj][m][n], 0, 0, 0); } \
        __builtin_amdgcn_s_setprio(0); } while (0)
#define PG8_WAIT_V(n) asm volatile("s_waitcnt vmcnt(" #n ")" ::: "memory")
#define PG8_WAIT_L(n) asm volatile("s_waitcnt lgkmcnt(" #n ")" ::: "memory")
#define PG8_BAR __builtin_amdgcn_s_barrier()
#define PG8_SCHED __builtin_amdgcn_sched_barrier(0)
#define PG8_TA(u) (g.A + (size_t)(u).pm * C::pmA + (size_t)(u).pn * C::pnA)
#define PG8_TB(u) (g.B + (size_t)(u).pm * C::pmB + (size_t)(u).pn * C::pnB)
    Unit cur, nxt; int ui = 0;
    if (!S.next(0, cur)) return;
    f32x4 acc[2][2][4][2];
#pragma unroll
    for (int a = 0; a < 2; ++a)
#pragma unroll
        for (int b = 0; b < 2; ++b)
#pragma unroll
            for (int m = 0; m < 4; ++m)
#pragma unroll
                for (int n = 0; n < 2; ++n) acc[a][b][m][n] = (f32x4){0.f, 0.f, 0.f, 0.f};
    bf16x8 At[4][2], B0[2][2], B1[2][2];
    const char* cA = PG8_TA(cur); const char* cB = PG8_TB(cur);
    if constexpr (SP2) {
        PG8_STAGE(PG8_SB(0, 0), cB, voffB); PG8_STAGE(PG8_SB(0, 1), cB + hstepB, voffB); PG8_STAGE(PG8_SA(0, 0), cA, voffA); PG8_STAGE(PG8_SA(0, 1), cA + hstepA, voffA);
        if (wr == 1) PG8_BAR;
        PG8_WAIT_V(2); PG8_BAR;
        PG8_STAGE(PG8_SB(1, 0), cB + kstep, voffB); PG8_STAGE(PG8_SA(1, 0), cA + kstep, voffA); PG8_STAGE(PG8_SB(1, 1), cB + hstepB + kstep, voffB);
        PG8_WAIT_V(6); PG8_BAR;
    } else {
        PG8_STAGE(PG8_SB(0, 0), cB, voffB); PG8_STAGE(PG8_SA(0, 0), cA, voffA); PG8_STAGE(PG8_SB(0, 1), cB + hstepB, voffB); PG8_STAGE(PG8_SA(0, 1), cA + hstepA, voffA);
        if (wr == 1) PG8_BAR;
        PG8_WAIT_V(4); PG8_BAR;
        PG8_STAGE(PG8_SB(1, 0), cB + kstep, voffB); PG8_STAGE(PG8_SA(1, 0), cA + kstep, voffA); PG8_STAGE(PG8_SB(1, 1), cB + hstepB + kstep, voffB);
        PG8_WAIT_V(6); PG8_BAR;
    }
    for (;;) {
        const bool has_next = S.next(ui + 1, nxt);
        const char* nA = has_next ? PG8_TA(nxt) : cA; const char* nB = has_next ? PG8_TB(nxt) : cB;
#pragma nounroll
        for (int t = 0; t < nt; t += 2) {
            const bool last = (t == nt - 2);
            const char* a1 = cA + (size_t)(t + 1) * kstep;
            const char* a2 = last ? nA : cA + (size_t)(t + 2) * kstep; const char* b2 = last ? nB : cB + (size_t)(t + 2) * kstep;
            const char* a3 = a2 + kstep; const char* b3 = b2 + kstep;
            if constexpr (SP2) {
            PG8_LDB(B0, 0, 0); PG8_LDB(B1, 0, 1); PG8_SCHED; PG8_LDA(At, 0, 0); PG8_STAGE(PG8_SA(1, 1), a1 + hstepA, voffA);
            PG8_WAIT_V(8); PG8_WAIT_L(0); PG8_BAR; PG8_MMA(0, 0, At, B0); PG8_MMA(0, 1, At, B1); PG8_BAR; PG8_SCHED;
            PG8_LDA(At, 0, 1); PG8_STAGE(PG8_SB(0, 0), b2, voffB); PG8_STAGE(PG8_SB(0, 1), b2 + hstepB, voffB); PG8_STAGE(PG8_SA(0, 0), a2, voffA);
            PG8_WAIT_V(8); PG8_WAIT_L(0); PG8_BAR; PG8_MMA(1, 0, At, B0); PG8_MMA(1, 1, At, B1); PG8_BAR; PG8_SCHED;
            PG8_LDB(B0, 1, 0); PG8_LDB(B1, 1, 1); PG8_SCHED; PG8_LDA(At, 1, 0); PG8_STAGE(PG8_SA(0, 1), a2 + hstepA, voffA);
            PG8_WAIT_V(8); PG8_WAIT_L(0); PG8_BAR; PG8_MMA(0, 0, At, B0); PG8_MMA(0, 1, At, B1); PG8_BAR; PG8_SCHED;
            PG8_LDA(At, 1, 1); PG8_STAGE(PG8_SB(1, 0), b3, voffB); PG8_STAGE(PG8_SB(1, 1), b3 + hstepB, voffB); PG8_STAGE(PG8_SA(1, 0), a3, voffA);
            PG8_WAIT_V(8); PG8_WAIT_L(0); PG8_BAR; PG8_MMA(1, 0, At, B0); PG8_MMA(1, 1, At, B1); PG8_BAR; PG8_SCHED;
            } else {
            PG8_LDB(B0, 0, 0); PG8_SCHED; PG8_LDA(At, 0, 0); PG8_STAGE(PG8_SA(1, 1), a1 + hstepA, voffA);
            PG8_WAIT_L(8); PG8_BAR; PG8_WAIT_L(0); PG8_MMA(0, 0, At, B0); PG8_BAR; PG8_SCHED;
            PG8_LDB(B1, 0, 1); PG8_STAGE(PG8_SB(0, 0), b2, voffB);
            PG8_BAR; PG8_WAIT_L(0); PG8_MMA(0, 1, At, B1); PG8_BAR;
            PG8_LDA(At, 0, 1); PG8_STAGE(PG8_SA(0, 0), a2, voffA);
            PG8_BAR; PG8_WAIT_L(0); PG8_MMA(1, 0, At, B0); PG8_BAR; PG8_SCHED;
            PG8_STAGE(PG8_SB(0, 1), b2 + hstepB, voffB);
            PG8_WAIT_V(6); PG8_BAR; PG8_MMA(1, 1, At, B1); PG8_BAR;
            PG8_LDB(B0, 1, 0); PG8_SCHED; PG8_LDA(At, 1, 0); PG8_STAGE(PG8_SA(0, 1), a2 + hstepA, voffA);
            PG8_WAIT_L(8); PG8_BAR; PG8_WAIT_L(0); PG8_MMA(0, 0, At, B0); PG8_BAR; PG8_SCHED;
            PG8_LDB(B1, 1, 1); PG8_STAGE(PG8_SB(1, 0), b3, voffB);
            PG8_BAR; PG8_WAIT_L(0); PG8_MMA(0, 1, At, B1); PG8_BAR;
            PG8_LDA(At, 1, 1); PG8_STAGE(PG8_SA(1, 0), a3, voffA);
            PG8_BAR; PG8_WAIT_L(0); PG8_MMA(1, 0, At, B0); PG8_BAR; PG8_SCHED;
            PG8_STAGE(PG8_SB(1, 1), b3 + hstepB, voffB);
            PG8_WAIT_V(6); PG8_BAR; PG8_MMA(1, 1, At, B1); PG8_BAR;
            }
        }
        if constexpr (ALIGN_EPI) { if (wr == 0) PG8_BAR; }
        E(acc, cur, wr, wc, fr, fq);
        if (!has_next) break;
#pragma unroll
        for (int a = 0; a < 2; ++a)
#pragma unroll
            for (int b = 0; b < 2; ++b)
#pragma unroll
                for (int m = 0; m < 4; ++m)
#pragma unroll
                    for (int n = 0; n < 2; ++n) acc[a][b][m][n] = (f32x4){0.f, 0.f, 0.f, 0.f};
        cur = nxt; cA = nA; cB = nB; ++ui;
        if constexpr (ALIGN_EPI) { if (wr == 1) PG8_BAR; }
    }
    PG8_WAIT_V(0);
    if constexpr (!ALIGN_EPI) { if (wr == 0) PG8_BAR; }
    PG8_BAR;
#undef PG8_SA
#undef PG8_SB
#undef PG8_STAGE
#undef PG8_LDA
#undef PG8_LDB
#undef PG8_MMA
#undef PG8_WAIT_V
#undef PG8_WAIT_L
#undef PG8_BAR
#undef PG8_SCHED
#undef PG8_TA
#undef PG8_TB
}
}

namespace att {
using bf16 = __hip_bfloat16;
constexpr int   D = 128, NW = 8, QBLK = 32, KVBLK = 64;
constexpr float SCALE = 0.088388347648318440f;
constexpr float THR = 8.f;
constexpr int LDQ = 8192, LDK = 8192, LDO = 2048;
constexpr size_t SHM_V = KVBLK * D * 2, SHM_K = KVBLK * D * 2, SHM_ATTN = 2 * SHM_V + 2 * SHM_K + NW * 64 * 4;
using bf16x8 = __attribute__((ext_vector_type(8))) short;
using s16x4  = __attribute__((ext_vector_type(4))) short;
using f32x16 = __attribute__((ext_vector_type(16))) float;
using u32x4  = __attribute__((ext_vector_type(4))) unsigned;
#define KSWZ(row, colB) ((row) * 256 + ((colB) ^ (((row) & 7) << 4)))
#define SBAR() __builtin_amdgcn_sched_barrier(0)
__device__ __forceinline__ int crow(int r, int hi) { return (r & 3) + 8 * (r >> 2) + 4 * hi; }
__device__ __forceinline__ unsigned cvtpk(float lo, float hi) { unsigned r; asm volatile("v_cvt_pk_bf16_f32 %0, %1, %2" : "=v"(r) : "v"(lo), "v"(hi)); return r; }
__device__ __forceinline__ bf16x8 ld8(const bf16* p) { return *reinterpret_cast<const bf16x8*>(p); }

__device__ __forceinline__ void partialSM(f32x16& p0, f32x16& p1, float& m_reg, float& mn, float& alpha) {
  constexpr float C = SCALE * 1.4426950408889634f;
  float pmax = p0[0]; for (int r = 1; r < 16; ++r) pmax = fmaxf(pmax, p0[r]); for (int r = 0; r < 16; ++r) pmax = fmaxf(pmax, p1[r]);
  { auto rr = __builtin_amdgcn_permlane32_swap(__float_as_uint(pmax), __float_as_uint(pmax), false, false);
    pmax = fmaxf(__uint_as_float(rr[0]), __uint_as_float(rr[1])); }
  if (__builtin_expect(__all(pmax - m_reg <= THR / SCALE), 1)) { mn = m_reg; alpha = 1.f; }
  else { mn = fmaxf(m_reg, pmax); alpha = __builtin_amdgcn_exp2f((m_reg - mn) * C); m_reg = mn; }
  float mnC = -mn * C;
  for (int r = 0; r < 16; ++r) p0[r] = fmaf(p0[r], C, mnC); for (int r = 0; r < 16; ++r) p1[r] = fmaf(p1[r], C, mnC);
  for (int r = 0; r < 16; ++r) p0[r] = __builtin_amdgcn_exp2f(p0[r]);
}
__device__ __forceinline__ void finishSM(f32x16& p0, f32x16& p1, float alpha, float& l_reg, bf16x8& pa0, bf16x8& pa1, bf16x8& pa2, bf16x8& pa3) {
  for (int r = 0; r < 16; ++r) p1[r] = __builtin_amdgcn_exp2f(p1[r]);
  float ps = 0; for (int r = 0; r < 16; ++r) ps += p0[r]; for (int r = 0; r < 16; ++r) ps += p1[r];
  { auto rr = __builtin_amdgcn_permlane32_swap(__float_as_uint(ps), __float_as_uint(ps), false, false);
    ps = __uint_as_float(rr[0]) + __uint_as_float(rr[1]); }
  l_reg = l_reg * alpha + ps;
#define PK4(P, BASE, OUT) do { unsigned a0 = cvtpk(P[BASE + 0], P[BASE + 1]), a1 = cvtpk(P[BASE + 2], P[BASE + 3]);   \
    unsigned b0 = cvtpk(P[BASE + 4], P[BASE + 5]), b1 = cvtpk(P[BASE + 6], P[BASE + 7]);                              \
    auto r0 = __builtin_amdgcn_permlane32_swap(a0, b0, false, false); auto r1 = __builtin_amdgcn_permlane32_swap(a1, b1, false, false); \
    u32x4 w = {r0[0], r1[0], r0[1], r1[1]}; OUT = *reinterpret_cast<bf16x8*>(&w); } while (0)
  PK4(p0, 0, pa0); PK4(p0, 8, pa1); PK4(p1, 0, pa2); PK4(p1, 8, pa3);
#undef PK4
}
__device__ __forceinline__ void qkt(f32x16& p0, f32x16& p1, const bf16* Ks, const bf16x8* qr, int r32, int hi) {
  p0 = f32x16{}; p1 = f32x16{};
  for (int d0 = 0; d0 < 8; ++d0) { int cb = (d0 * 16 + hi * 8) * 2;
    bf16x8 b0 = *reinterpret_cast<const bf16x8*>((const char*)Ks + KSWZ(r32, cb));
    bf16x8 b1 = *reinterpret_cast<const bf16x8*>((const char*)Ks + KSWZ(32 + r32, cb));
    p0 = __builtin_amdgcn_mfma_f32_32x32x16_bf16(b0, qr[d0], p0, 0, 0, 0);
    p1 = __builtin_amdgcn_mfma_f32_32x32x16_bf16(b1, qr[d0], p1, 0, 0, 0); }
}
__device__ __forceinline__ int v_st(int k, int c) { const int kk = (k & ~0xC) | ((k & 4) << 1) | ((k & 8) >> 1); return ((kk >> 3) * 4 + (c >> 5)) * 512 + ((kk & 7) * 32 + (c & 31)) * 2; }
__device__ __forceinline__ int v_rd_base(int lane) { return ((lane & 3) << 3) | (((lane >> 2) & 3) << 6) | (((lane >> 4) & 1) << 5) | (((lane >> 5) & 1) << 8); }
constexpr int v_rd_off(int d0, int ks, int half) { return d0 * 512 + ks * 4096 + half * 2048; }
template <int OFF> __device__ __forceinline__ s16x4 tr_read(int vb) {
  s16x4 r; asm volatile("ds_read_b64_tr_b16 %0, %1 offset:%2" : "=&v"(r) : "v"(vb), "i"(OFF) : "memory"); return r;
}
template <int D0> __device__ __forceinline__ void pv_one(f32x16& od, int vb, bf16x8 pa0, bf16x8 pa1, bf16x8 pa2, bf16x8 pa3) {
  const s16x4 l0 = tr_read<v_rd_off(D0, 0, 0)>(vb), h0 = tr_read<v_rd_off(D0, 0, 1)>(vb), l1 = tr_read<v_rd_off(D0, 1, 0)>(vb), h1 = tr_read<v_rd_off(D0, 1, 1)>(vb);
  const s16x4 l2 = tr_read<v_rd_off(D0, 2, 0)>(vb), h2 = tr_read<v_rd_off(D0, 2, 1)>(vb), l3 = tr_read<v_rd_off(D0, 3, 0)>(vb), h3 = tr_read<v_rd_off(D0, 3, 1)>(vb);
  asm volatile("s_waitcnt lgkmcnt(0)" ::: "memory"); SBAR();
#define PK(L, H) (bf16x8){L[0], L[1], L[2], L[3], H[0], H[1], H[2], H[3]}
  od = __builtin_amdgcn_mfma_f32_32x32x16_bf16(pa0, PK(l0, h0), od, 0, 0, 0);
  od = __builtin_amdgcn_mfma_f32_32x32x16_bf16(pa1, PK(l1, h1), od, 0, 0, 0);
  od = __builtin_amdgcn_mfma_f32_32x32x16_bf16(pa2, PK(l2, h2), od, 0, 0, 0);
  od = __builtin_amdgcn_mfma_f32_32x32x16_bf16(pa3, PK(l3, h3), od, 0, 0, 0);
#undef PK
}
__device__ __forceinline__ void pv_d0(f32x16* o, int vb, bf16x8 pa0, bf16x8 pa1, bf16x8 pa2, bf16x8 pa3) {
  pv_one<0>(o[0], vb, pa0, pa1, pa2, pa3); pv_one<1>(o[1], vb, pa0, pa1, pa2, pa3); pv_one<2>(o[2], vb, pa0, pa1, pa2, pa3); pv_one<3>(o[3], vb, pa0, pa1, pa2, pa3);
}

__device__ __forceinline__ void attn_dense_body(const bf16* Qb, const bf16* __restrict__ Kh, const bf16* __restrict__ Vh,
                                                bf16* Ob, int seq, char* lds) {
  constexpr int SDEPTH = 2;
  const int tid = threadIdx.x, wid = tid >> 6, lane = tid & 63, r32 = lane & 31, hi = lane >> 5;
  bf16* V_lds = (bf16*)lds; bf16* K_lds = (bf16*)(lds + 2 * SHM_V);
  float* ws = (float*)(lds + 2 * SHM_V + 2 * SHM_K) + wid * 64; float* li_l = ws; float* al_l = ws + 32;
  float m_reg = -1e30f, l_reg = 0; f32x16 o[4] = {}; bf16x8 qr[8];
  const bf16* Qw = Qb + (long)(wid * QBLK + r32) * LDQ + hi * 8;
#pragma unroll
  for (int d0 = 0; d0 < 8; ++d0) qr[d0] = ld8(Qw + d0 * 16);
  const int sr = tid >> 4, sc = (tid & 15) * 8, vst0 = v_st(sr, sc), vst1 = v_st(32 + sr, sc);
  const int vb0 = (int)(uintptr_t)V_lds + v_rd_base(lane);
  struct { bf16x8 vs0, vs1, ks0, ks1; } sr_[SDEPTH];
#define SLOAD(i, k0) do { sr_[i].vs0 = ld8(&Vh[(long)((k0) + sr) * LDK + sc]); sr_[i].vs1 = ld8(&Vh[(long)((k0) + 32 + sr) * LDK + sc]); \
    sr_[i].ks0 = ld8(&Kh[(long)((k0) + sr) * LDK + sc]); sr_[i].ks1 = ld8(&Kh[(long)((k0) + 32 + sr) * LDK + sc]); } while (0)
#define SWRITE(b, i) do { *(bf16x8*)((char*)V_lds + (b) * SHM_V + vst0) = sr_[i].vs0;          \
    *(bf16x8*)((char*)V_lds + (b) * SHM_V + vst1) = sr_[i].vs1; int kc = sc * 2;               \
    *(bf16x8*)((char*)K_lds + (b) * SHM_K + KSWZ(sr, kc)) = sr_[i].ks0;                       \
    *(bf16x8*)((char*)K_lds + (b) * SHM_K + KSWZ(32 + sr, kc)) = sr_[i].ks1; } while (0)
#define SWAIT() do { asm volatile("s_waitcnt vmcnt(4)" ::: "memory"); } while (0)
#define RESC(a) do { if (__any((a) < 1.f)) { if (hi == 0) al_l[r32] = (a); asm volatile("s_waitcnt lgkmcnt(0)" ::: "memory"); \
    for (int d = 0; d < 4; ++d) for (int r = 0; r < 16; ++r) o[d][r] *= al_l[crow(r, hi)]; } } while (0)
  f32x16 pA0, pA1, pB0, pB1; float mnA, mnB, alA, alB; bf16x8 pa0, pa1, pa2, pa3; const int NT = seq / KVBLK;
  constexpr int SE = 0, SO = SDEPTH - 1;
  SLOAD(SE, 0); asm volatile("s_waitcnt vmcnt(0)" ::: "memory"); SWRITE(0, SE); __syncthreads();
  qkt(pA0, pA1, K_lds, qr, r32, hi); partialSM(pA0, pA1, m_reg, mnA, alA);
  SLOAD(SO, KVBLK); if (2 < NT) SLOAD(SE, 2 * KVBLK);
  SWAIT(); SWRITE(1, SO); __syncthreads();
  for (int j = 1; j + 1 < NT; j += 2) {
    SBAR(); qkt(pB0, pB1, (bf16*)((char*)K_lds + SHM_K), qr, r32, hi);
    finishSM(pA0, pA1, alA, l_reg, pa0, pa1, pa2, pa3); SBAR();
    SLOAD(SO, (j + SDEPTH) * KVBLK); SBAR();
    pv_d0(o, vb0, pa0, pa1, pa2, pa3); partialSM(pB0, pB1, m_reg, mnB, alB);
    __syncthreads(); SWAIT(); SWRITE(0, SE);
    RESC(alB); __syncthreads();
    SBAR(); qkt(pA0, pA1, K_lds, qr, r32, hi);
    finishSM(pB0, pB1, alB, l_reg, pa0, pa1, pa2, pa3); SBAR();
    if (j + 3 < NT) SLOAD(SE, (j + 1 + SDEPTH) * KVBLK); SBAR();
    pv_d0(o, vb0 + (int)SHM_V, pa0, pa1, pa2, pa3); partialSM(pA0, pA1, m_reg, mnA, alA);
    __syncthreads(); SWAIT(); SWRITE(1, SO);
    RESC(alA); __syncthreads();
  }
  SBAR(); qkt(pB0, pB1, (bf16*)((char*)K_lds + SHM_K), qr, r32, hi);
  finishSM(pA0, pA1, alA, l_reg, pa0, pa1, pa2, pa3); SBAR();
  pv_d0(o, vb0, pa0, pa1, pa2, pa3); partialSM(pB0, pB1, m_reg, mnB, alB);
  __syncthreads(); RESC(alB);
  finishSM(pB0, pB1, alB, l_reg, pa0, pa1, pa2, pa3); SBAR();
  pv_d0(o, vb0 + (int)SHM_V, pa0, pa1, pa2, pa3);
  if (hi == 0) li_l[r32] = l_reg; asm volatile("s_waitcnt lgkmcnt(0)" ::: "memory");
  float rli[16];
#pragma unroll
  for (int r = 0; r < 16; ++r) rli[r] = __builtin_amdgcn_rcpf(li_l[crow(r, hi)]);
  unsigned short* Ow = (unsigned short*)Ob + (long)(wid * QBLK) * LDO;
#pragma unroll
  for (int r = 0; r < 16; ++r) { int orow = crow(r, hi);
#pragma unroll
    for (int d0 = 0; d0 < 4; ++d0) Ow[(long)orow * LDO + d0 * 32 + r32] = (unsigned short)(cvtpk(o[d0][r] * rli[r], 0.f) & 0xffffu); }
#undef SLOAD
#undef SWRITE
#undef SWAIT
#undef RESC
}
}


namespace att8 {
using bf16 = __hip_bfloat16;
typedef int v8i __attribute__((ext_vector_type(8)));
typedef int v4i __attribute__((ext_vector_type(4)));
using f32x16 = __attribute__((ext_vector_type(16))) float;
typedef float f2 __attribute__((ext_vector_type(2)));
constexpr int D = 128, NW = 8, QBLK = 32, KVBLK = 64;
constexpr float SCALE = 0.088388347648318440f;
constexpr float THR = 8.f;
constexpr int LDQ8 = 2048, LDK8 = 128, LDO = 2048;
constexpr int SHM_K8 = 8192, SHM_V8 = 8192;
#define SB8() __builtin_amdgcn_sched_barrier(0)
constexpr int SCL = 0x7f7f7f7f;
__device__ __forceinline__ int crow(int r, int hi) { return (r & 3) + 8 * (r >> 2) + 4 * hi; }
__host__ __device__ __forceinline__ int vpos(int key) { return 32 * ((key >> 2) & 1) + 16 * (key >> 5) + (key & 3) + 4 * ((key >> 3) & 3); }
__host__ __device__ __forceinline__ int vkey(int pos) { const int hi = pos >> 5, e = pos & 31, p = e >> 4, r = e & 15; return 32 * p + (r & 3) + 8 * (r >> 2) + 4 * hi; }

__device__ __forceinline__ void partialSM(f32x16& p0, f32x16& p1, float& m_reg, float& mn, float& alpha) {
  constexpr float C = SCALE * 1.4426950408889634f;
  float pmax = p0[0]; for (int r = 1; r < 16; ++r) pmax = fmaxf(pmax, p0[r]); for (int r = 0; r < 16; ++r) pmax = fmaxf(pmax, p1[r]);
  { auto rr = __builtin_amdgcn_permlane32_swap(__float_as_uint(pmax), __float_as_uint(pmax), false, false);
    pmax = fmaxf(__uint_as_float(rr[0]), __uint_as_float(rr[1])); }
  if (__builtin_expect(__all(pmax - m_reg <= THR / SCALE), 1)) { mn = m_reg; alpha = 1.f; }
  else { mn = fmaxf(m_reg, pmax); alpha = __builtin_amdgcn_exp2f((m_reg - mn) * C); m_reg = mn; }
  const float mnC = -mn * C; const f2 c2 = {C, C}, m2 = {mnC, mnC};
#pragma unroll
  for (int r = 0; r < 8; ++r) { f2 v = {p0[2 * r], p0[2 * r + 1]}; v = v * c2 + m2; p0[2 * r] = v.x; p0[2 * r + 1] = v.y;
                                f2 w = {p1[2 * r], p1[2 * r + 1]}; w = w * c2 + m2; p1[2 * r] = w.x; p1[2 * r + 1] = w.y; }
#pragma unroll
  for (int r = 0; r < 16; ++r) p0[r] = __builtin_amdgcn_exp2f(p0[r]);
}
__device__ __forceinline__ void finishSM(f32x16& p0, f32x16& p1, float alpha, float& l_reg, v8i& pa) {
  for (int r = 0; r < 16; ++r) p1[r] = __builtin_amdgcn_exp2f(p1[r]);
  f2 s2 = {p0[0], p0[1]};
#pragma unroll
  for (int r = 1; r < 8; ++r) s2 += (f2){p0[2 * r], p0[2 * r + 1]};
#pragma unroll
  for (int r = 0; r < 8; ++r) s2 += (f2){p1[2 * r], p1[2 * r + 1]};
  float ps = s2.x + s2.y;
  { auto rr = __builtin_amdgcn_permlane32_swap(__float_as_uint(ps), __float_as_uint(ps), false, false);
    ps = __uint_as_float(rr[0]) + __uint_as_float(rr[1]); }
  l_reg = l_reg * alpha + ps;
#pragma unroll
  for (int i = 0; i < 4; ++i) { int w = __builtin_amdgcn_cvt_pk_bf8_f32(p0[4 * i], p0[4 * i + 1], 0, false); w = __builtin_amdgcn_cvt_pk_bf8_f32(p0[4 * i + 2], p0[4 * i + 3], w, true); pa[i] = w; }
#pragma unroll
  for (int i = 0; i < 4; ++i) { int w = __builtin_amdgcn_cvt_pk_bf8_f32(p1[4 * i], p1[4 * i + 1], 0, false); w = __builtin_amdgcn_cvt_pk_bf8_f32(p1[4 * i + 2], p1[4 * i + 3], w, true); pa[4 + i] = w; }
}
__device__ __forceinline__ v8i ld32(const char* a, const char* b) { const v4i x = *(const v4i*)a, y = *(const v4i*)b; return (v8i){x[0], x[1], x[2], x[3], y[0], y[1], y[2], y[3]}; }
__device__ __forceinline__ void qkt(f32x16& p0, f32x16& p1, const char* Ks, const v8i* qr, int kro, const int (&kx)[2][2]) {
  p0 = f32x16{}; p1 = f32x16{};
#pragma unroll
  for (int db = 0; db < 2; ++db) {
    const v8i k0 = ld32(Ks + kro + kx[db][0], Ks + kro + kx[db][1]);
    const v8i k1 = ld32(Ks + 4096 + kro + kx[db][0], Ks + 4096 + kro + kx[db][1]);
    p0 = __builtin_amdgcn_mfma_scale_f32_32x32x64_f8f6f4(k0, qr[db], p0, 0, 0, 0, SCL, 0, SCL);
    p1 = __builtin_amdgcn_mfma_scale_f32_32x32x64_f8f6f4(k1, qr[db], p1, 0, 0, 0, SCL, 0, SCL); }
}
__device__ __forceinline__ void pv(f32x16* o, const char* Vs, const v8i pa, int vro, const int (&vx)[2]) {
#pragma unroll
  for (int d0 = 0; d0 < 4; ++d0) { const v8i vf = ld32(Vs + d0 * 2048 + vro + vx[0], Vs + d0 * 2048 + vro + vx[1]);
    o[d0] = __builtin_amdgcn_mfma_scale_f32_32x32x64_f8f6f4(pa, vf, o[d0], 1, 0, 0, SCL, 0, SCL); }
}
__device__ __forceinline__ void attn_body(const unsigned char* Qb, const unsigned char* __restrict__ Kh, const unsigned char* __restrict__ Vh, unsigned char* Ob, int seq, char* lds) {
  const int tid = threadIdx.x, wid = tid >> 6, lane = tid & 63, r32 = lane & 31, hi = lane >> 5;
  char* V_lds = lds; char* K_lds = lds + 3 * SHM_V8;
  float* ws = (float*)(lds + 3 * SHM_V8 + 3 * SHM_K8) + wid * 64; float* li_l = ws; float* al_l = ws + 32;
  float m_reg = -1e30f, l_reg = 0; f32x16 o[4] = {}; v8i qr[2];
  const unsigned char* Qw = Qb + (long)(wid * QBLK + r32) * LDQ8 + hi * 32;
#pragma unroll
  for (int db = 0; db < 2; ++db) qr[db] = ld32((const char*)Qw + db * 64, (const char*)Qw + db * 64 + 16);
  const int skey = tid >> 3, skc = tid & 7, kst = skey * 128 + ((skc ^ ((skey >> 1) & 7)) << 4);
  const int sd = tid >> 2, svc = tid & 3, vst = sd * 64 + ((svc ^ ((sd >> 2) & 3)) << 4);
  const unsigned char* kg = Kh + skey * 128 + skc * 16;
  const unsigned char* vg = Vh + sd * 64 + svc * 16;
  const int kro = r32 * 128, ksw = (r32 >> 1) & 7, vro = r32 * 64, vsw = (r32 >> 2) & 3;
  int kx[2][2], vx[2];
#pragma unroll
  for (int db = 0; db < 2; ++db)
#pragma unroll
    for (int j = 0; j < 2; ++j) kx[db][j] = ((4 * db + 2 * hi + j) ^ ksw) << 4;
#pragma unroll
  for (int j = 0; j < 2; ++j) vx[j] = ((2 * hi + j) ^ vsw) << 4;
  struct { v4i ks, vs; } sr_[2];
#define SLOAD(i, k0) do { sr_[i].ks = *(const v4i*)(kg + (long)(k0) * 128); sr_[i].vs = *(const v4i*)(vg + (long)(k0) * 128); } while (0)
#define SWRITE(b, i) do { *(v4i*)(K_lds + (b) * SHM_K8 + kst) = sr_[i].ks; *(v4i*)(V_lds + (b) * SHM_V8 + vst) = sr_[i].vs; } while (0)
#define SWAIT() do { asm volatile("s_waitcnt vmcnt(2)" ::: "memory"); } while (0)
#define RESC(a) do { if (__any((a) < 1.f)) { if (hi == 0) al_l[r32] = (a); asm volatile("s_waitcnt lgkmcnt(0)" ::: "memory"); \
    for (int d = 0; d < 4; ++d) for (int r = 0; r < 16; ++r) o[d][r] *= al_l[crow(r, hi)]; } } while (0)
  f32x16 pA0, pA1, pB0, pB1; float mnA, mnB, alA, alB; v8i pa; const int NT = seq / KVBLK;
  int b_prev = 0, b_cur = 0, b_next = 1;
#define ROT3() do { b_prev = b_cur; b_cur = b_next; b_next = (b_next == 2) ? 0 : b_next + 1; } while (0)
  SLOAD(0, 0); asm volatile("s_waitcnt vmcnt(0)" ::: "memory"); SWRITE(0, 0); SLOAD(1, KVBLK); __syncthreads();
  qkt(pA0, pA1, K_lds, qr, kro, kx); partialSM(pA0, pA1, m_reg, mnA, alA);
  if (2 < NT) SLOAD(0, 2 * KVBLK);
  SWRITE(1, 1); __syncthreads();
  b_prev = 0; b_cur = 1; b_next = 2;
  for (int j = 1; j + 1 < NT; j += 2) {
    SB8(); qkt(pB0, pB1, K_lds + b_cur * SHM_K8, qr, kro, kx);
    finishSM(pA0, pA1, alA, l_reg, pa); SB8();
    if (j + 2 < NT) SLOAD(1, (j + 2) * KVBLK); SB8();
    pv(o, V_lds + b_prev * SHM_V8, pa, vro, vx); partialSM(pB0, pB1, m_reg, mnB, alB);
    SWRITE(b_next, 0);
    RESC(alB); __syncthreads(); ROT3();
    SB8(); qkt(pA0, pA1, K_lds + b_cur * SHM_K8, qr, kro, kx);
    finishSM(pB0, pB1, alB, l_reg, pa); SB8();
    if (j + 3 < NT) SLOAD(0, (j + 3) * KVBLK); SB8();
    pv(o, V_lds + b_prev * SHM_V8, pa, vro, vx); partialSM(pA0, pA1, m_reg, mnA, alA);
    if (j + 2 < NT) SWRITE(b_next, 1);
    RESC(alA); __syncthreads(); ROT3();
  }
  SB8(); qkt(pB0, pB1, K_lds + b_cur * SHM_K8, qr, kro, kx);
  finishSM(pA0, pA1, alA, l_reg, pa); SB8();
  pv(o, V_lds + b_prev * SHM_V8, pa, vro, vx); partialSM(pB0, pB1, m_reg, mnB, alB);
  RESC(alB);
  finishSM(pB0, pB1, alB, l_reg, pa); SB8();
  pv(o, V_lds + b_cur * SHM_V8, pa, vro, vx);
#undef ROT3
  if (hi == 0) li_l[r32] = l_reg; asm volatile("s_waitcnt lgkmcnt(0)" ::: "memory");
  float rli[16];
#pragma unroll
  for (int r = 0; r < 16; ++r) rli[r] = __builtin_amdgcn_rcpf(li_l[crow(r, hi)]);
  unsigned char* Ow = (unsigned char*)Ob + (long)(wid * QBLK) * LDO;
#pragma unroll
  for (int r = 0; r < 16; ++r) { int orow = crow(r, hi);
#pragma unroll
    for (int d0 = 0; d0 < 4; ++d0) Ow[(long)orow * LDO + d0 * 32 + r32] = (unsigned char)(__builtin_amdgcn_cvt_pk_fp8_f32(o[d0][r] * rli[r], 0.f, 0, false) & 0xff); }
#undef SLOAD
#undef SWRITE
#undef SWAIT
#undef RESC
}
}

constexpr int S_ = 16384, DM = 2048, FF = 5632, INW = 8192;
constexpr float EPS = 1e-6f;
constexpr size_t MiB = 1u << 20;
constexpr size_t WS_G1 = 0;
constexpr size_t WS_TW = 256 * 1024;
constexpr size_t WS_CTL = 512 * 1024, CTL_BYTES = 16384;
constexpr size_t WS_W = 1 * MiB;
constexpr size_t WS_WGU = WS_W, WS_WD = WS_W + 44 * MiB;
constexpr size_t WS_WIN8 = WS_W + 12 * MiB, WS_WAO8 = WS_W + 52 * MiB;
constexpr size_t WS_WIN = WS_W, WS_WAO = WS_W + 32 * MiB, WS_WF = WS_W + 40 * MiB, WS_WOUT = WS_W + 44 * MiB;
constexpr size_t WS_U = 68 * MiB;
constexpr size_t WS_T = 132 * MiB;
constexpr size_t WS_R1 = 196 * MiB;
constexpr size_t WS_Q8 = 452 * MiB, WS_K8 = 484 * MiB, WS_VT8 = 492 * MiB;
constexpr size_t WS_END = 500 * MiB;
constexpr int LDS_BYTES = 147456, LDSCTL_OFF = 131072;
constexpr int NPHASE = 16;

typedef float f32x4 __attribute__((ext_vector_type(4)));
typedef unsigned u32x4 __attribute__((ext_vector_type(4)));
typedef unsigned u32x2 __attribute__((ext_vector_type(2)));
#define LAS __attribute__((address_space(3)))
#define LDS_WAIT() asm volatile("s_waitcnt lgkmcnt(0)" ::: "memory")


#define XB_TMO      128
#define XB_XCNT(j)  (256  + 64 * (j))
#define XB_XSUB(j)  (1280 + 64 * (j))
#define XB_XGEN(j)  (2304 + 64 * (j))
#define XB_TOP      3328
#define XB_TOPGEN   3392
#define XCD_BAR_WORDS 3456
#define XB_SPIN_CAP (1u << 18)
__device__ __forceinline__ unsigned xb_ld(unsigned* p)              { return __hip_atomic_load(p, __ATOMIC_RELAXED, __HIP_MEMORY_SCOPE_AGENT); }
__device__ __forceinline__ unsigned xb_add(unsigned* p, unsigned v) { return __hip_atomic_fetch_add(p, v, __ATOMIC_RELAXED, __HIP_MEMORY_SCOPE_AGENT); }
__device__ __forceinline__ unsigned xb_xcc_id() { return (unsigned)__builtin_amdgcn_s_getreg((3 << 11) | 20) & 0xFu; }
#define XB_SPIN(cond, bar) do { unsigned _sp = 0; while (cond) { __builtin_amdgcn_s_sleep(1); \
    if ((++_sp & 255u) == 0u) { if (xb_ld(&(bar)[XB_TMO])) break; if (_sp > XB_SPIN_CAP) { atomicAdd(&(bar)[XB_TMO], 1u); break; } } } } while (0)
struct XcdBarrier { unsigned* bar; unsigned x; volatile LAS unsigned* st; };
__device__ __forceinline__ XcdBarrier xcd_barrier_post(unsigned* bar, volatile LAS unsigned* st) {
    XcdBarrier b; b.bar = bar; b.x = xb_xcc_id(); b.st = st;
    if (threadIdx.x == 0) (void)xb_add(&bar[XB_XCNT(b.x)], 1u);
    return b;
}
__device__ __forceinline__ void xcd_barrier_complete(unsigned* bar, unsigned x, unsigned& nloc, unsigned& nx) {
    const unsigned G = gridDim.x * gridDim.y * gridDim.z;
    unsigned sum, cnt, mine, sp = 0u;
    for (;;) {
        sum = 0u; cnt = 0u; mine = 0u;
#pragma unroll
        for (unsigned j = 0; j < 16; ++j) { const unsigned c = xb_ld(&bar[XB_XCNT(j)]); sum += c; cnt += (c > 0u) ? 1u : 0u; mine = (j == x) ? c : mine; }
        if (sum == G) break;
        __builtin_amdgcn_s_sleep(1);
        if ((++sp & 255u) == 0u) { if (xb_ld(&bar[XB_TMO])) break; if (sp > XB_SPIN_CAP) { atomicAdd(&bar[XB_TMO], 1u); break; } }
    }
    nloc = mine > 0u ? mine : 1u; nx = cnt > 0u ? cnt : 1u;
}
__device__ __forceinline__ void xcd_barrier(const XcdBarrier& b) {
    asm volatile("s_waitcnt vmcnt(0)" ::: "memory");
    __syncthreads();
    if (threadIdx.x == 0) {
        unsigned* bar = b.bar;
        __builtin_amdgcn_s_waitcnt(0);
        unsigned nloc = b.st[0], nx = b.st[1];
        if (nloc == 0u) { xcd_barrier_complete(bar, b.x, nloc, nx); b.st[0] = nloc; b.st[1] = nx; }
        const unsigned old = xb_add(&bar[XB_XSUB(b.x)], 1u);
        const unsigned gen = old / nloc;
        if (old + 1u == (gen + 1u) * nloc) {
            __builtin_amdgcn_fence(__ATOMIC_RELEASE, "agent");
            asm volatile("s_waitcnt vmcnt(0)" ::: "memory");
            const unsigned og = xb_add(&bar[XB_TOP], 1u);
            const unsigned tg = og / nx;
            if (og + 1u == (tg + 1u) * nx) xb_add(&bar[XB_TOPGEN], 1u);
            else XB_SPIN(xb_ld(&bar[XB_TOPGEN]) == tg, bar);
            __builtin_amdgcn_fence(__ATOMIC_ACQUIRE, "agent");
            xb_add(&bar[XB_XGEN(b.x)], 1u);
            asm volatile("s_waitcnt vmcnt(0)" ::: "memory");
        } else {
            XB_SPIN(xb_ld(&bar[XB_XGEN(b.x)]) == gen, bar);
            __builtin_amdgcn_fence(__ATOMIC_ACQUIRE, "agent");
            asm volatile("s_waitcnt vmcnt(0)" ::: "memory");
        }
    }
    __syncthreads();
}

__device__ __forceinline__ float wave_sum(float v) {
    v += __builtin_bit_cast(float, __builtin_amdgcn_update_dpp(0, __builtin_bit_cast(int, v), 0xB1, 0xf, 0xf, false));
    v += __builtin_bit_cast(float, __builtin_amdgcn_update_dpp(0, __builtin_bit_cast(int, v), 0x4E, 0xf, 0xf, false));
    v += __builtin_bit_cast(float, __builtin_amdgcn_update_dpp(0, __builtin_bit_cast(int, v), 0x141, 0xf, 0xf, false));
    v += __builtin_bit_cast(float, __builtin_amdgcn_update_dpp(0, __builtin_bit_cast(int, v), 0x140, 0xf, 0xf, false));
    v += __shfl_xor(v, 16); v += __shfl_xor(v, 32);
    return v;
}
using pg8::cvt_pk_bf16; using pg8::bf_lo; using pg8::bf_hi;

__device__ __forceinline__ void transpose_item(const float* __restrict__ W, int N, unsigned short* __restrict__ WT, int ldt, int k0, int n0, int drow0, LAS float* scr, int lane) {
#pragma unroll
    for (int i = 0; i < 32; ++i) { const int kk = 2 * i + (lane >> 5); scr[kk * 33 + (lane & 31)] = W[(size_t)(k0 + kk) * N + n0 + (lane & 31)]; }
    LDS_WAIT(); asm volatile("" ::: "memory");
    const int c = lane & 7;
#pragma unroll
    for (int j = 0; j < 4; ++j) { const int n = (lane >> 3) + 8 * j; const LAS float* s = scr + (8 * c) * 33 + n;
        u32x4 o; o.x = cvt_pk_bf16(s[0 * 33], s[1 * 33]); o.y = cvt_pk_bf16(s[2 * 33], s[3 * 33]); o.z = cvt_pk_bf16(s[4 * 33], s[5 * 33]); o.w = cvt_pk_bf16(s[6 * 33], s[7 * 33]);
        *(u32x4*)(WT + (size_t)(drow0 + n) * ldt + k0 + 8 * c) = o; }
    LDS_WAIT(); asm volatile("" ::: "memory");
}
__device__ __forceinline__ void transpose_item8(const float* __restrict__ W, int N, unsigned char* __restrict__ WT8, int ldt, int k0, int n0, int drow0, LAS float* scr, int lane) {
#pragma unroll
    for (int i = 0; i < 32; ++i) { const int kk = 2 * i + (lane >> 5); scr[kk * 33 + (lane & 31)] = W[(size_t)(k0 + kk) * N + n0 + (lane & 31)]; }
    LDS_WAIT(); asm volatile("" ::: "memory");
    const int c = lane & 7;
#pragma unroll
    for (int j = 0; j < 4; ++j) { const int n = (lane >> 3) + 8 * j; const LAS float* s = scr + (8 * c) * 33 + n;
        int w0 = __builtin_amdgcn_cvt_pk_fp8_f32(s[0 * 33], s[1 * 33], 0, false); w0 = __builtin_amdgcn_cvt_pk_fp8_f32(s[2 * 33], s[3 * 33], w0, true);
        int w1 = __builtin_amdgcn_cvt_pk_fp8_f32(s[4 * 33], s[5 * 33], 0, false); w1 = __builtin_amdgcn_cvt_pk_fp8_f32(s[6 * 33], s[7 * 33], w1, true);
        u32x2 o; o.x = (unsigned)w0; o.y = (unsigned)w1;
        *(u32x2*)(WT8 + (size_t)(drow0 + n) * ldt + k0 + 8 * c) = o; }
    LDS_WAIT(); asm volatile("" ::: "memory");
}
__device__ __forceinline__ void transpose_plain(const float* W, int K, int N, unsigned short* WT, int it, LAS float* scr, int lane) {
    const int nblk = N / 32, kb = it / nblk, nb = it % nblk;
    transpose_item(W, N, WT, K, 64 * kb, 32 * nb, 32 * nb, scr, lane);
}
__device__ __forceinline__ void convert_ffn(const float* Wg, const float* Wu, const float* Wd, unsigned short* WGU, unsigned short* WD, LAS float* scr, int gw, int NGW, int lane) {
    constexpr int I_G = (DM / 64) * (FF / 32), I_D = (FF / 64) * (DM / 32);
    for (int it = gw; it < 2 * I_G + I_D; it += NGW) {
        int r = it;
        if (r < 2 * I_G) { const bool up = r >= I_G; if (up) r -= I_G; const int nblk = FF / 32, kb = r / nblk, nb = r % nblk, n0 = 32 * nb;
            transpose_item(up ? Wu : Wg, FF, WGU, DM, 64 * kb, n0, (n0 >> 7) * 256 + (up ? 128 : 0) + (n0 & 127), scr, lane); continue; }
        r -= 2 * I_G; transpose_plain(Wd, FF, DM, WD, r, scr, lane);
    }
}
template <int NR>
__device__ __forceinline__ void norm_rows(const float* xrow, const float* g, unsigned short* orow, int lane, size_t rstep) {
    f32x4 v[NR][8]; float s[NR];
#pragma unroll
    for (int r = 0; r < NR; ++r) { const f32x4* xr = (const f32x4*)(xrow + r * rstep) + lane;
#pragma unroll
        for (int j = 0; j < 8; ++j) v[r][j] = xr[64 * j]; }
#pragma unroll
    for (int r = 0; r < NR; ++r) { float a = 0.f;
#pragma unroll
        for (int j = 0; j < 8; ++j) a += (v[r][j].x * v[r][j].x + v[r][j].y * v[r][j].y) + (v[r][j].z * v[r][j].z + v[r][j].w * v[r][j].w);
        s[r] = a; }
#pragma unroll
    for (int r = 0; r < NR; ++r) s[r] = wave_sum(s[r]);
#pragma unroll
    for (int r = 0; r < NR; ++r) { const float rstd = 1.0f / sqrtf(s[r] * (1.f / DM) + EPS);
        u32x2* o8 = (u32x2*)(orow + r * rstep) + lane;
#pragma unroll
        for (int j = 0; j < 8; ++j) { const f32x4 gv = ((const f32x4*)g + lane)[64 * j]; u32x2 w; w.x = cvt_pk_bf16(v[r][j].x * rstd * gv.x, v[r][j].y * rstd * gv.y); w.y = cvt_pk_bf16(v[r][j].z * rstd * gv.z, v[r][j].w * rstd * gv.w); o8[64 * j] = w; } }
}
template <int NR, bool NEXT, bool BBF, bool OBF, bool U8 = false>
__device__ __forceinline__ void res_norm_rows(const unsigned short* trow, const void* brow, const float* post_g, float wgt, void* orow, const float* pre_g, unsigned short* urow, int lane, unsigned char* u8row, size_t rstep) {
    f32x4 t[NR][8], b[NR][8]; float s[NR];
#pragma unroll
    for (int r = 0; r < NR; ++r) { const u32x2* tr = (const u32x2*)(trow + r * rstep) + lane;
#pragma unroll
        for (int j = 0; j < 8; ++j) { const u32x2 w = tr[64 * j]; t[r][j] = (f32x4){bf_lo(w.x), bf_hi(w.x), bf_lo(w.y), bf_hi(w.y)}; } }
#pragma unroll
    for (int r = 0; r < NR; ++r) {
#pragma unroll
        for (int j = 0; j < 8; ++j) { if (BBF) { const u32x2 wb = ((const u32x2*)((const unsigned short*)brow + r * rstep) + lane)[64 * j]; b[r][j] = (f32x4){bf_lo(wb.x), bf_hi(wb.x), bf_lo(wb.y), bf_hi(wb.y)}; }
                                      else b[r][j] = ((const f32x4*)((const float*)brow + r * rstep) + lane)[64 * j]; } }
#pragma unroll
    for (int r = 0; r < NR; ++r) { float a = 0.f;
#pragma unroll
        for (int j = 0; j < 8; ++j) a += (t[r][j].x * t[r][j].x + t[r][j].y * t[r][j].y) + (t[r][j].z * t[r][j].z + t[r][j].w * t[r][j].w);
        s[r] = a; }
#pragma unroll
    for (int r = 0; r < NR; ++r) s[r] = wave_sum(s[r]);
    float s2[NR];
#pragma unroll
    for (int r = 0; r < NR; ++r) { const float rstd = wgt / sqrtf(s[r] * (1.f / DM) + EPS); float a = 0.f;
#pragma unroll
        for (int j = 0; j < 8; ++j) { const f32x4 g = ((const f32x4*)post_g + lane)[64 * j];
            t[r][j] = b[r][j] + t[r][j] * rstd * g;
            if (OBF) { u32x2 wo; wo.x = cvt_pk_bf16(t[r][j].x, t[r][j].y); wo.y = cvt_pk_bf16(t[r][j].z, t[r][j].w); ((u32x2*)((unsigned short*)orow + r * rstep) + lane)[64 * j] = wo; }
            else ((f32x4*)((float*)orow + r * rstep) + lane)[64 * j] = t[r][j];
            a += (t[r][j].x * t[r][j].x + t[r][j].y * t[r][j].y) + (t[r][j].z * t[r][j].z + t[r][j].w * t[r][j].w); }
        s2[r] = a; }
    if (NEXT) {
#pragma unroll
        for (int r = 0; r < NR; ++r) s2[r] = wave_sum(s2[r]);
#pragma unroll
        for (int r = 0; r < NR; ++r) { const float r2 = 1.0f / sqrtf(s2[r] * (1.f / DM) + EPS);
            u32x2* o8 = (u32x2*)(urow + r * rstep) + lane;
#pragma unroll
            for (int j = 0; j < 8; ++j) { const f32x4 gv = ((const f32x4*)pre_g + lane)[64 * j]; const f32x4 uu = t[r][j] * r2 * gv;
                u32x2 w; w.x = cvt_pk_bf16(uu.x, uu.y); w.y = cvt_pk_bf16(uu.z, uu.w); o8[64 * j] = w;
                if (U8) { int q = __builtin_amdgcn_cvt_pk_fp8_f32(uu.x, uu.y, 0, false); q = __builtin_amdgcn_cvt_pk_fp8_f32(uu.z, uu.w, q, true); ((unsigned*)(u8row + r * rstep) + lane)[64 * j] = (unsigned)q; } } }
    }
}
__device__ __forceinline__ void qk_rope_row(unsigned short* row, int s, const float* qg, const float* kg, int lane) {
    const int sec = lane >> 5, half = (lane >> 4) & 1, i0 = (2 * lane) & 31;
    const float pos = (float)(sec == 0 ? (s >> 6) : (s & 63));
    const float L = 13.287712379549449f / 32.f;
    float cs[2], sn[2];
#pragma unroll
    for (int e = 0; e < 2; ++e) { const float fr = exp2f(-(float)(i0 + e) * L); float rev = pos * fr * 0.15915494309189535f; rev -= floorf(rev);
        sn[e] = __builtin_amdgcn_sinf(rev); cs[e] = __builtin_amdgcn_cosf(rev); }
    const float gq0 = qg[2 * lane], gq1 = qg[2 * lane + 1], gk0 = kg[2 * lane], gk1 = kg[2 * lane + 1];
    unsigned w[20];
#pragma unroll
    for (int h = 0; h < 20; ++h) w[h] = ((const unsigned*)(row + h * 128))[lane];
#pragma unroll
    for (int h = 0; h < 20; ++h) {
        const float x0 = bf_lo(w[h]), x1 = bf_hi(w[h]);
        const float rstd = 1.0f / sqrtf(wave_sum(x0 * x0 + x1 * x1) * (1.f / 128.f) + EPS);
        const float y0 = x0 * rstd * (h < 16 ? gq0 : gk0), y1 = x1 * rstd * (h < 16 ? gq1 : gk1);
        const float p0 = __shfl_xor(y0, 16), p1 = __shfl_xor(y1, 16);
        const float o0 = half ? (y0 * cs[0] + p0 * sn[0]) : (y0 * cs[0] - p0 * sn[0]);
        const float o1 = half ? (y1 * cs[1] + p1 * sn[1]) : (y1 * cs[1] - p1 * sn[1]);
        ((unsigned*)(row + h * 128))[lane] = cvt_pk_bf16(o0, o1);
    }
}


__device__ __forceinline__ void qk_rope_row8(const unsigned short* row, int s, const float* qg, const float* kg, unsigned char* Q8, unsigned char* K8, int lane) {
    const int sec = lane >> 5, half = (lane >> 4) & 1, i0 = (2 * lane) & 31;
    const float pos = (float)(sec == 0 ? (s >> 6) : (s & 63));
    const float L = 13.287712379549449f / 32.f;
    float cs[2], sn[2];
#pragma unroll
    for (int e = 0; e < 2; ++e) { const float fr = exp2f(-(float)(i0 + e) * L); float rev = pos * fr * 0.15915494309189535f; rev -= floorf(rev);
        sn[e] = __builtin_amdgcn_sinf(rev); cs[e] = __builtin_amdgcn_cosf(rev); }
    const float gq0 = qg[2 * lane], gq1 = qg[2 * lane + 1], gk0 = kg[2 * lane], gk1 = kg[2 * lane + 1];
    unsigned short w[20];
#pragma unroll
    for (int h = 0; h < 20; ++h) w[h] = ((const unsigned short*)((const unsigned char*)row + h * 128))[lane];
#pragma unroll
    for (int h = 0; h < 20; ++h) {
        typedef float f32x2v __attribute__((ext_vector_type(2)));
        const f32x2v xx = __builtin_amdgcn_cvt_pk_f32_fp8((int)w[h], false); const float x0 = xx.x, x1 = xx.y;
        const float rstd = 1.0f / sqrtf(wave_sum(x0 * x0 + x1 * x1) * (1.f / 128.f) + EPS);
        const float y0 = x0 * rstd * (h < 16 ? gq0 : gk0), y1 = x1 * rstd * (h < 16 ? gq1 : gk1);
        const float p0 = __shfl_xor(y0, 16), p1 = __shfl_xor(y1, 16);
        const float o0 = half ? (y0 * cs[0] + p0 * sn[0]) : (y0 * cs[0] - p0 * sn[0]);
        const float o1 = half ? (y1 * cs[1] + p1 * sn[1]) : (y1 * cs[1] - p1 * sn[1]);
        const unsigned short w8 = (unsigned short)(__builtin_amdgcn_cvt_pk_fp8_f32(o0, o1, 0, false) & 0xffff);
        if (h < 16) ((unsigned short*)(Q8 + (size_t)s * 2048 + h * 128))[lane] = w8;
        else ((unsigned short*)(K8 + ((size_t)(h - 16) * S_ + s) * 128))[lane] = w8;
    }
}
__device__ __forceinline__ void v_transpose_item(const unsigned short* R1, unsigned char* Vt8, int item, LAS unsigned char* scr, int lane) {
    const int t = item >> 2, kvh = item & 3;
    const unsigned char* src = (const unsigned char*)R1 + (size_t)(64 * t) * (INW * 2) + 2560 + kvh * 128;
#pragma unroll
    for (int i = 0; i < 8; ++i) { const int rr = 8 * i + (lane >> 3), c16 = lane & 7; const u32x4 v = *(const u32x4*)(src + (size_t)rr * (INW * 2) + c16 * 16); *(LAS u32x4*)(scr + rr * 128 + c16 * 16) = v; }
    LDS_WAIT(); asm volatile("" ::: "memory");
#pragma unroll
    for (int dh = 0; dh < 2; ++dh) { const int d = dh * 64 + lane;
        u32x4 o4[4];
#pragma unroll
        for (int q = 0; q < 16; ++q) { unsigned ww = 0;
#pragma unroll
            for (int e = 0; e < 4; ++e) { const int key = att8::vkey(4 * q + e); ww |= (unsigned)(*(const LAS unsigned char*)(scr + key * 128 + d)) << (8 * e); }
            o4[q >> 2][q & 3] = ww; }
        unsigned char* dst = Vt8 + (((size_t)kvh * 256 + t) * 128 + d) * 64;
#pragma unroll
        for (int q = 0; q < 4; ++q) *(u32x4*)(dst + 16 * q) = o4[q]; }
    LDS_WAIT(); asm volatile("" ::: "memory");
}

#define SINGLE_ARG(...) __VA_ARGS__
struct Args { const float* in[20]; float* out; unsigned char* ws; int ph_lo, ph_hi; };

__global__ void __launch_bounds__(512, 2) mk_fwd(Args args) {
    extern __shared__ __attribute__((aligned(16))) unsigned char lds[];
    cg::grid_group grid = cg::this_grid();
    const int tid = threadIdx.x, lane = tid & 63, wave = __builtin_amdgcn_readfirstlane(tid >> 6);
    const int G = gridDim.x, bx = blockIdx.x;
    const int gw = bx * 8 + wave, NGW = G * 8;
    unsigned char* ws = args.ws;
    unsigned short* const G1 = (unsigned short*)(ws + WS_G1); float* const TW = (float*)(ws + WS_TW);
    unsigned short* const U = (unsigned short*)(ws + WS_U); unsigned short* const T = (unsigned short*)(ws + WS_T); unsigned short* const R1 = (unsigned short*)(ws + WS_R1);
    const float* x = args.in[0]; float* out = args.out;
    unsigned short* const HB1 = (unsigned short*)args.out;
    unsigned short* const HB2 = (unsigned short*)(ws + WS_R1 + 176 * MiB);
    LAS unsigned char* ldsl = (LAS unsigned char*)lds;
    LAS float* scr = (LAS float*)(ldsl + wave * 16384);
    const int lo = args.ph_lo, hi = args.ph_hi;
    for (int u_ = tid; u_ < 64; u_ += 512) ((LAS unsigned*)(ldsl + LDSCTL_OFF))[u_] = 0u;
    __syncthreads();
    const XcdBarrier xbar = xcd_barrier_post((unsigned*)(ws + WS_CTL), (volatile LAS unsigned*)(ldsl + LDSCTL_OFF + 32));
#ifndef F1_AL
#define F1_AL false
#endif
#ifndef F1_SP
#define F1_SP true
#endif
#ifndef PHASE_MASK
#define PHASE_MASK 0xFFFF
#endif
#define IN(k) (((PHASE_MASK >> (k)) & 1) && lo <= (k) && (k) < hi)
#if PROBE_TS
    unsigned long long* const TS = (unsigned long long*)(ws + 768 * 1024);
#define STAMP(k) do { if (bx == 0 && tid == 0) TS[(k)] = __builtin_amdgcn_s_memrealtime(); } while (0)
#else
#define STAMP(k) do { } while (0)
#endif
    STAMP(0);
    if (hi < 0) grid.sync();
#define SEAM(k) do { if (IN(k) && IN((k) + 1)) xcd_barrier(xbar); STAMP((k) + 1); } while (0)
#define GEMM_PHASE_X(CFG, EPI, AL, SP, Aptr, Bptr, M_, N_, ...) do { pg8::Gemm g_{(const char*)(Aptr), (const char*)(Bptr)}; pg8::StaticOrder So_; So_.init((M_), (N_), G, bx, EPI::IDEMPOTENT ? REP_GEMM : EPI::REPX); \
        EPI E_{__VA_ARGS__}; pg8::gemm_phase<CFG, EPI, pg8::StaticOrder, AL, SP, false>(ldsl, g_, So_, E_); } while (0)
#define GEMM_PHASE(CFG, EPI, ...) GEMM_PHASE_X(SINGLE_ARG(CFG), SINGLE_ARG(EPI), true, true, __VA_ARGS__)
#define GEMM_PHASE_F8(CFG, EPI, Aptr, Bptr, M_, N_, ...) do { pg8::Gemm g_{(const char*)(Aptr), (const char*)(Bptr)}; pg8::StaticOrder So_; So_.init((M_), (N_), G, bx, 1); \
        EPI E_{__VA_ARGS__}; pg8::gemm_phase<CFG, EPI, pg8::StaticOrder, true, true, true>(ldsl, g_, So_, E_); } while (0)
    typedef pg8::Cfg<2048u, 2048u, (size_t)128 * 2048, (size_t)128 * 2048, (size_t)256 * 2048, 0, 0, (size_t)256 * 2048, 1024> CfgF8;
    typedef pg8::Cfg<512u, (unsigned)(128 * INW * 2), (size_t)128 * 512, (size_t)INW * 2, 0, 0, 256, (size_t)2 * INW * 2, 128> CfgF1;
    typedef pg8::Cfg<512u, 512u, (size_t)128 * 512, (size_t)128 * 512, 0, 0, 0, (size_t)256 * 512, 256> CfgF2;

    if (IN(0)) {
        for (int rp_ = 0; rp_ < REP_CONV; ++rp_) convert_ffn(args.in[2], args.in[3], args.in[4], (unsigned short*)(ws + WS_WGU), (unsigned short*)(ws + WS_WD), scr, gw, NGW, lane);
        for (int e = bx * 512 + tid; e < 256 * 256; e += G * 512) { const int r = e >> 8, c = e & 255, ro = r >> 7, i = r & 127, ri = c >> 7, j = c & 127, a = (i * j) & 127;
            const float cv = cospif((float)a * (1.f / 64.f)), sv = sinpif((float)a * (1.f / 64.f));
            const float v = (ro == ri) ? cv : (ro == 0 ? sv : -sv);
            G1[e] = (unsigned short)(cvt_pk_bf16(v * 0.08838834764831845f, 0.f) & 0xffffu); }
        for (int e = bx * 512 + tid; e < 128 * 128; e += G * 512) { const int c = e >> 7, b = e & 127, a = (b * c) & 16383;
            TW[2 * e] = cospif((float)a * (1.f / 8192.f)); TW[2 * e + 1] = -sinpif((float)a * (1.f / 8192.f)); }
        for (int m = gw; m < S_; m += 2 * NGW) norm_rows<2>(x + (size_t)m * DM, args.in[1], U + (size_t)m * DM, lane, (size_t)NGW * DM);
    }
    SEAM(0);
    if (IN(1)) GEMM_PHASE(SINGLE_ARG(pg8::StdCfg<DM, DM, DM>), pg8::EpiSwiglu, U, ws + WS_WGU, S_, 2 * FF, R1, FF);
    SEAM(1);
    if (IN(2)) GEMM_PHASE(SINGLE_ARG(pg8::StdCfg<FF, FF, FF>), pg8::EpiStore, R1, ws + WS_WD, S_, DM, T, DM);
    SEAM(2);
    if (IN(3)) {
        for (int m = gw; m < S_; m += 2 * NGW) res_norm_rows<2, true, false, true, true>(T + (size_t)m * DM, x + (size_t)m * DM, args.in[5], 0.5f, HB1 + (size_t)m * DM, args.in[6], U + (size_t)m * DM, lane, ws + WS_Q8 + (size_t)m * DM, (size_t)NGW * DM);
        constexpr int I_IN = (DM / 64) * (INW / 32), I_AO = (DM / 64) * (DM / 32), I_F = (1024 / 64) * (DM / 32);
        for (int rp_ = 0; rp_ < REP_CONV; ++rp_) for (int it = gw; it < I_IN + 2 * I_AO + I_F; it += NGW) { int r = it;
            if (r < I_IN) { const int nblk = INW / 32, kb = r / nblk, nb = r % nblk, n0 = 32 * nb;
                if (n0 < 3072) transpose_item8(args.in[7], INW, ws + WS_WIN8, DM, 64 * kb, n0, n0, scr, lane);
                else if (n0 < 4096) transpose_item(args.in[7], INW, (unsigned short*)(ws + WS_WIN), DM, 64 * kb, n0, n0 - 3072, scr, lane);
                else if (n0 < 6144) transpose_item8(args.in[7], INW, ws + WS_WIN8, DM, 64 * kb, n0, n0 - 1024, scr, lane);
                else transpose_item(args.in[7], INW, (unsigned short*)(ws + WS_WIN), DM, 64 * kb, n0, n0 - 5120, scr, lane);
                continue; } r -= I_IN;
            if (r < I_AO) { const int nblk = DM / 32, kb = r / nblk, nb = r % nblk; transpose_item8(args.in[11], DM, ws + WS_WAO8, DM, 64 * kb, 32 * nb, 32 * nb, scr, lane); continue; } r -= I_AO;
            if (r < I_F) { transpose_plain(args.in[12], 1024, DM, (unsigned short*)(ws + WS_WF), r, scr, lane); continue; } r -= I_F;
            transpose_plain(args.in[13], DM, DM, (unsigned short*)(ws + WS_WOUT), r, scr, lane); }
    }
    SEAM(3);
    if (IN(4)) {
        GEMM_PHASE_F8(CfgF8, pg8::EpiStore8, ws + WS_Q8, ws + WS_WIN8, S_, 5120, (unsigned char*)R1, INW * 2, 12, 8192);
        GEMM_PHASE(SINGLE_ARG(pg8::StdCfg<DM, DM, DM>), pg8::EpiStore, U, ws + WS_WIN, S_, 3072, R1 + 3072, INW, 4, 2048);
    }
    SEAM(4);
    if (IN(5)) {
        for (int rp_ = 0; rp_ < REP_ROPE; ++rp_) for (int m = gw; m < S_; m += NGW) qk_rope_row8(R1 + (size_t)m * INW, m, args.in[9], args.in[10], ws + WS_Q8, ws + WS_K8, lane);
        for (int rp_ = 0; rp_ < REP_ROPE; ++rp_) for (int it = gw; it < 1024; it += NGW) v_transpose_item(R1, ws + WS_VT8, it, (LAS unsigned char*)scr, lane);
        __syncthreads();
        GEMM_PHASE_X(CfgF1, pg8::EpiZt, F1_AL, F1_SP, G1, R1 + 3072, 8 * 256, 64 * 256, U);
    }
    SEAM(5);
    if (IN(6)) GEMM_PHASE(CfgF2, pg8::EpiYt, G1, U, 256, 131072, T, TW);
    SEAM(6);
    if (IN(7)) GEMM_PHASE(CfgF2, pg8::EpiXf, G1, T, 256, 131072, R1 + 3072, INW);
    SEAM(7);
    if (IN(8)) {
        for (int rp_ = 0; rp_ < REP_ATTN; ++rp_)
        for (int u = bx; u < 1024; u += G) { const int kvh = u >> 8, w = u & 255, qh = 4 * kvh + (w & 3), qb = w >> 2;
            __syncthreads();
            att8::attn_body(ws + WS_Q8 + (size_t)qb * 256 * 2048 + qh * 128, ws + WS_K8 + (size_t)kvh * S_ * 128, ws + WS_VT8 + (size_t)kvh * 128 * S_,
                            (unsigned char*)U + (size_t)qb * 256 * DM + qh * 128, S_, (char*)lds);
        }
        __syncthreads();
    }
    SEAM(8);
    if (IN(9)) GEMM_PHASE_F8(CfgF8, SINGLE_ARG(pg8::EpiGate<false, true>), U, ws + WS_WAO8, S_, DM, T, DM, R1 + 4096, INW * 2, args.in[8]);
    if (IN(10)) GEMM_PHASE(SINGLE_ARG(pg8::StdCfg<INW, 1024, 1024>), pg8::EpiGate<true>, R1 + 3072, ws + WS_WF, S_, DM, T, DM, R1 + 4096 + DM, INW, args.in[8] + DM);
    SEAM(10);
    if (IN(11)) GEMM_PHASE(SINGLE_ARG(pg8::StdCfg<DM, DM, DM>), pg8::EpiStore, T, ws + WS_WOUT, S_, DM, U, DM);
    SEAM(11);
    if (IN(12)) {
        for (int m = gw; m < S_; m += 2 * NGW) res_norm_rows<2, true, true, true>(U + (size_t)m * DM, HB1 + (size_t)m * DM, args.in[14], 1.0f, HB2 + (size_t)m * DM, args.in[15], U + (size_t)m * DM, lane, nullptr, (size_t)NGW * DM);
        for (int rp_ = 0; rp_ < REP_CONV; ++rp_) convert_ffn(args.in[16], args.in[17], args.in[18], (unsigned short*)(ws + WS_WGU), (unsigned short*)(ws + WS_WD), scr, gw, NGW, lane);
    }
    SEAM(12);
    if (IN(13)) GEMM_PHASE(SINGLE_ARG(pg8::StdCfg<DM, DM, DM>), pg8::EpiSwiglu, U, ws + WS_WGU, S_, 2 * FF, R1, FF);
    SEAM(13);
    if (IN(14)) GEMM_PHASE(SINGLE_ARG(pg8::StdCfg<FF, FF, FF>), pg8::EpiStore, R1, ws + WS_WD, S_, DM, T, DM);
    SEAM(14);
    if (IN(15)) {
        for (int m = gw; m < S_; m += 2 * NGW) res_norm_rows<2, false, true, false>(T + (size_t)m * DM, HB2 + (size_t)m * DM, args.in[19], 0.5f, out + (size_t)m * DM, nullptr, nullptr, lane, nullptr, (size_t)NGW * DM);
    }
#if PROBE_TS
    __syncthreads();
    if (bx == 0) { STAMP(16); __syncthreads();
        float v1 = 0.f, v2 = 0.f;
        for (int k = 0; k < 16; ++k) { const float d = (float)(long long)(TS[k + 1] - TS[k]) * 0.01f; if ((PROBE_M1 >> k) & 1) v1 += d; if ((PROBE_M2 >> k) & 1) v2 += d; }
        if (tid == 0) out[0] += v1;
        for (int e = tid; e < 4096; e += 512) out[DM + e] += v2 * (1.f / 16.f); }
#endif
#undef IN
#undef SEAM
#undef GEMM_PHASE
#undef GEMM_PHASE_X
#undef GEMM_PHASE_F8
}

extern "C" void kernel_launch(void* const* d_in, const int* in_sizes, int n_in, void* d_out, int out_size, void* d_ws, size_t ws_size, hipStream_t stream) {
    static int grid = 0;
    if (grid == 0) {
        if (n_in != 20 || in_sizes[0] != S_ * DM || out_size != S_ * DM || ws_size < WS_END) {
            fprintf(stderr, "kernel_launch: shape/workspace mismatch: n_in %d in0 %d out %d ws %zu (need %zu)\n", n_in, n_in > 0 ? in_sizes[0] : -1, out_size, ws_size, (size_t)WS_END); grid = -1; return; }
        int dev = 0, cus = 0, per_cu = 0;
        if (hipGetDevice(&dev) != hipSuccess || hipDeviceGetAttribute(&cus, hipDeviceAttributeMultiprocessorCount, dev) != hipSuccess) { fprintf(stderr, "kernel_launch: device query failed\n"); grid = -1; return; }
        if (hipFuncSetAttribute((const void*)mk_fwd, hipFuncAttributeMaxDynamicSharedMemorySize, LDS_BYTES) != hipSuccess) { fprintf(stderr, "kernel_launch: hipFuncSetAttribute failed\n"); grid = -1; return; }
        if (hipOccupancyMaxActiveBlocksPerMultiprocessor(&per_cu, (const void*)mk_fwd, 512, LDS_BYTES) != hipSuccess || per_cu < 1) { fprintf(stderr, "kernel_launch: occupancy query says %d blocks per CU\n", per_cu); per_cu = 1; }
        (void)hipGetLastError();
        grid = cus;
    }
    if (grid < 0) return;
    if (hipMemsetAsync((char*)d_ws + WS_CTL, 0, CTL_BYTES, stream) != hipSuccess) { fprintf(stderr, "kernel_launch: memset of barrier words failed\n"); return; }
    Args a{};
    for (int i = 0; i < 20; ++i) a.in[i] = (const float*)d_in[i];
    a.out = (float*)d_out; a.ws = (unsigned char*)d_ws;
#if MK_PER_PHASE
    for (int p = 0; p < NPHASE; ++p) { a.ph_lo = p; a.ph_hi = p + 1;
        hipLaunchKernelGGL(mk_fwd, dim3(grid), dim3(512), LDS_BYTES, stream, a);
        const hipError_t le = hipPeekAtLastError(); if (le != hipSuccess) { fprintf(stderr, "kernel_launch: launch %d failed: %s\n", p, hipGetErrorName(le)); break; } }
#else
    a.ph_lo = 0; a.ph_hi = NPHASE;
    void* kargs[] = {&a};
    const hipError_t e = hipLaunchCooperativeKernel((const void*)mk_fwd, dim3(grid), dim3(512), kargs, LDS_BYTES, stream);
    if (e != hipSuccess) fprintf(stderr, "kernel_launch: cooperative launch failed: %s (grid %d)\n", hipGetErrorString(e), grid);
#endif
}
```
